# Optimizing an MI355X kernel written in HIP

```python
import jax, jax.numpy as jnp
from jax import lax
import numpy as np

D_MODEL = 4096
BATCH = 2
SEQ = 4096
DEPTH = 2

D_MIX = D_MODEL
HEAD_DIM = 128
A_GROUPS = 8
A_CH = 128
A_WIDTH = A_GROUPS * A_CH
CHUNK = 128
B_HEADS = 12
B_WIDTH = B_HEADS * HEAD_DIM
C_HEADS = 12
C_NOPE = 128
C_ROPE = 64
C_VDIM = 128
C_WIDTH = C_HEADS * C_VDIM
Q_LORA = 768
KV_LORA = 512
ROPE_THETA = 10000.0
D_IN = 3 * A_WIDTH + 4 * B_WIDTH + Q_LORA + KV_LORA + C_ROPE + C_WIDTH
EPS = 1e-6
Q_BLOCK = 128

kernel_name = "hybrid_gmlp_stickbreak_mla_parallel_heads"


def rmsnorm(x, g):
    xf = x.astype(jnp.float32)
    xf = xf * lax.rsqrt(jnp.mean(xf * xf, axis=-1, keepdims=True) + EPS)
    return (xf * g.astype(jnp.float32)).astype(x.dtype)


def gated_norm(y, g, z):
    return rmsnorm(y, g) * jax.nn.silu(z)


def rope(x, cos, sin):
    half = x.shape[-1] // 2
    x1, x2 = x[..., :half], x[..., half:]
    out = jnp.concatenate([x1 * cos - x2 * sin, x2 * cos + x1 * sin], axis=-1)
    return out.astype(x.dtype)


def chunked_gmlp(u, v, g_v, w_s, b_s):
    bn, s, _ = u.shape
    u = jax.nn.gelu(u)
    v = rmsnorm(jax.nn.gelu(v).reshape(bn, s, A_GROUPS, A_CH), g_v)
    v = v.reshape(bn, s // CHUNK, CHUNK, A_GROUPS, A_CH)
    causal = jnp.tril(jnp.ones((CHUNK, CHUNK), dtype=bool))
    w = jnp.where(causal[None], w_s, 0.0).astype(v.dtype)
    sv = jnp.einsum('gts,bcsgd->bctgd', w, v) + b_s.T[None, None, :, :, None]
    return u * sv.reshape(bn, s, A_WIDTH)


def stick_breaking(q, k, v):
    bn, s, h, d = q.shape
    nb = s // Q_BLOCK
    scale = d ** -0.5
    kpos = jnp.arange(s)
    qb = q.reshape(bn, nb, Q_BLOCK, h, d).transpose(1, 0, 2, 3, 4)

    def block(args):
        qi, bi = args
        z = jnp.einsum('bthd,bshd->bhts', qi, k).astype(jnp.float32) * scale
        qpos = bi * Q_BLOCK + jnp.arange(Q_BLOCK)
        strict = kpos[None, :] < qpos[:, None]
        log_keep = jnp.where(strict, jax.nn.log_sigmoid(-z), 0.0)
        after = lax.cumsum(log_keep, axis=3, reverse=True) - log_keep
        a = jnp.where(strict, jnp.exp(jax.nn.log_sigmoid(z) + after), 0.0)
        return jnp.einsum('bhts,bshd->bthd', a.astype(v.dtype), v)

    out = lax.map(block, (qb, jnp.arange(nb)))
    return out.transpose(1, 0, 2, 3, 4).reshape(bn, s, h * d)


def mla(c_q, c_kv, k_rope, cos, sin, g_q, g_kv, w_uq, w_ukv):
    bn, s, _ = c_q.shape
    q = jnp.einsum('bsr,rn->bsn', rmsnorm(c_q, g_q), w_uq).reshape(bn, s, C_HEADS, C_NOPE + C_ROPE)
    q_nope = q[..., :C_NOPE]
    q_rope = rope(q[..., C_NOPE:], cos, sin)
    kv = jnp.einsum('bsr,rn->bsn', rmsnorm(c_kv, g_kv), w_ukv).reshape(bn, s, C_HEADS, C_NOPE + C_VDIM)
    k_nope, v = kv[..., :C_NOPE], kv[..., C_NOPE:]
    k_r = rope(k_rope, cos[:, :, 0], sin[:, :, 0])
    scale = (C_NOPE + C_ROPE) ** -0.5
    nb = s // Q_BLOCK
    kpos = jnp.arange(s)
    qn_b = q_nope.reshape(bn, nb, Q_BLOCK, C_HEADS, C_NOPE).transpose(1, 0, 2, 3, 4)
    qr_b = q_rope.reshape(bn, nb, Q_BLOCK, C_HEADS, C_ROPE).transpose(1, 0, 2, 3, 4)

    def block(args):
        qn, qr, bi = args
        z = (jnp.einsum('bthd,bshd->bhts', qn, k_nope)
             + jnp.einsum('bthr,bsr->bhts', qr, k_r)).astype(jnp.float32) * scale
        qpos = bi * Q_BLOCK + jnp.arange(Q_BLOCK)
        causal = kpos[None, :] <= qpos[:, None]
        p = jax.nn.softmax(jnp.where(causal, z, -jnp.inf), axis=-1)
        return jnp.einsum('bhts,bshd->bthd', p.astype(v.dtype), v)

    out = lax.map(block, (qn_b, qr_b, jnp.arange(nb)))
    return out.transpose(1, 0, 2, 3, 4).reshape(bn, s, C_WIDTH)


def hybrid_layer(x, cos, sin, g_pre, w_in, a_g_v, a_w_s, a_b_s,
                 c_g_q, c_g_kv, c_w_uq, c_w_ukv, g_out, w_out):
    bn, s, _ = x.shape
    h = rmsnorm(x, g_pre)
    proj = jnp.einsum('bsd,dn->bsn', h, w_in)
    sizes = [A_WIDTH, A_WIDTH, A_WIDTH, B_WIDTH, B_WIDTH, B_WIDTH, B_WIDTH,
             Q_LORA, KV_LORA, C_ROPE, C_WIDTH]
    offsets, acc = [], 0
    for sz in sizes[:-1]:
        acc += sz
        offsets.append(acc)
    u_a, v_a, z_a, q_b, k_b, v_b, z_b, cq, ckv, kr, z_c = jnp.split(proj, offsets, axis=-1)

    y_a = chunked_gmlp(u_a, v_a, a_g_v, a_w_s, a_b_s)
    y_b = stick_breaking(q_b.reshape(bn, s, B_HEADS, HEAD_DIM),
                         k_b.reshape(bn, s, B_HEADS, HEAD_DIM),
                         v_b.reshape(bn, s, B_HEADS, HEAD_DIM))
    y_c = mla(cq, ckv, kr, cos, sin, c_g_q, c_g_kv, c_w_uq, c_w_ukv)

    y = jnp.concatenate([
        gated_norm(y_a, g_out[:A_WIDTH], z_a),
        gated_norm(y_b, g_out[A_WIDTH:A_WIDTH + B_WIDTH], z_b),
        gated_norm(y_c, g_out[A_WIDTH + B_WIDTH:], z_c),
    ], axis=-1)
    return x + jnp.einsum('bsn,nd->bsd', y, w_out)


def setup_inputs(seed: int = 0) -> dict:
    key = jax.random.key(seed)
    ks = jax.random.split(key, 16)
    f32 = jnp.float32

    def nrm(k, shape, scale):
        return jax.random.normal(k, shape, f32) * scale

    x = jax.random.normal(ks[0], (BATCH, SEQ, D_MODEL), f32)
    offset = jax.random.randint(ks[1], (BATCH, 1), 0, 1024, dtype=jnp.int32)
    positions = (offset + jnp.arange(SEQ, dtype=jnp.int32)[None, :]).astype(jnp.int32)
    return {
        "x": x,
        "positions": positions,
        "g_pre": 1.0 + nrm(ks[2], (DEPTH, D_MODEL), 0.02),
        "w_in": nrm(ks[3], (DEPTH, D_MODEL, D_IN), D_MODEL ** -0.5),
        "a_g_v": 1.0 + nrm(ks[4], (DEPTH, A_GROUPS, A_CH), 0.02),
        "a_w_s": nrm(ks[5], (DEPTH, A_GROUPS, CHUNK, CHUNK), CHUNK ** -0.5),
        "a_b_s": 1.0 + nrm(ks[6], (DEPTH, A_GROUPS, CHUNK), 0.02),
        "c_g_q": 1.0 + nrm(ks[7], (DEPTH, Q_LORA), 0.02),
        "c_g_kv": 1.0 + nrm(ks[8], (DEPTH, KV_LORA), 0.02),
        "c_w_uq": nrm(ks[9], (DEPTH, Q_LORA, C_HEADS * (C_NOPE + C_ROPE)), Q_LORA ** -0.5),
        "c_w_ukv": nrm(ks[10], (DEPTH, KV_LORA, C_HEADS * (C_NOPE + C_VDIM)), KV_LORA ** -0.5),
        "g_out": 1.0 + nrm(ks[11], (DEPTH, D_MIX), 0.02),
        "w_out": nrm(ks[12], (DEPTH, D_MIX, D_MODEL), D_MIX ** -0.5),
        "g_final": 1.0 + nrm(ks[13], (D_MODEL,), 0.02),
    }


def reference(x, positions, g_pre, w_in, a_g_v, a_w_s, a_b_s, c_g_q, c_g_kv,
              c_w_uq, c_w_ukv, g_out, w_out, g_final):
    inv_freq = 1.0 / (ROPE_THETA ** (jnp.arange(0, C_ROPE, 2, dtype=jnp.float32) / C_ROPE))
    ang = positions.astype(jnp.float32)[..., None] * inv_freq
    cos = jnp.cos(ang)[:, :, None, :]
    sin = jnp.sin(ang)[:, :, None, :]
    h = x
    for l in range(DEPTH):
        h = hybrid_layer(h, cos, sin, g_pre[l], w_in[l], a_g_v[l], a_w_s[l], a_b_s[l],
                         c_g_q[l], c_g_kv[l], c_w_uq[l], c_w_ukv[l], g_out[l], w_out[l])
    return rmsnorm(h, g_final)
```

```cpp
#include <hip/hip_runtime.h>
#include <hip/hip_cooperative_groups.h>
#include <cstdio>
#include <cstdint>
namespace cg = cooperative_groups;

#ifndef N_LAUNCH
#define N_LAUNCH 1
#endif

#define DI __device__ __forceinline__
#define LAS __attribute__((address_space(3)))
typedef unsigned short bf16_t;
typedef short bf16x8 __attribute__((ext_vector_type(8)));
typedef float f32x4 __attribute__((ext_vector_type(4)));
typedef float f32x16 __attribute__((ext_vector_type(16)));
typedef unsigned u32x4 __attribute__((ext_vector_type(4)));
typedef unsigned u32x2 __attribute__((ext_vector_type(2)));
typedef float f32x2_t __attribute__((ext_vector_type(2)));
typedef __bf16 bf16x2_t __attribute__((ext_vector_type(2)));

constexpr int M_TOK = 8192, SEQ = 4096, DM = 4096, DIN = 12096, DINP = 12288, NHEAD = 12;
constexpr int OFF_UA = 0, OFF_VA = 1024, OFF_ZA = 2048, OFF_QB = 3072, OFF_KB = 4608, OFF_VB = 6144, OFF_ZB = 7680,
              OFF_CQ = 9216, OFF_CKV = 9984, OFF_KR = 10496, OFF_ZC = 10560;
constexpr int QL = 768, KVL = 512, NUQ = 2304, NUKV = 3072;
constexpr float EPS = 1e-6f, LOG2E = 1.4426950408889634f;
constexpr float QSB = 0.08838834764831845f * LOG2E;
constexpr float QSC = 0.07216878364870323f * LOG2E;

constexpr size_t MiB = 1u << 20;
constexpr size_t WS_CTL = 0, CTL_BYTES = 1 * MiB;
constexpr size_t WS_WIN = 1 * MiB, WS_WOUT = 193 * MiB, WS_WUQ = 257 * MiB, WS_WUKV = 264 * MiB, WS_XB = 270 * MiB, WS_PROJ = 334 * MiB,
                 WS_VBT = 526 * MiB, WS_QC = 550 * MiB, WS_KNC = 586 * MiB, WS_VCT = 610 * MiB, WS_KR = 634 * MiB, WS_COS = 635 * MiB,
                 WS_SIN = 636 * MiB, WS_YG = 637 * MiB, WS_KC = 701 * MiB, WS_END = 829 * MiB;
constexpr int C_SSX = 0;
constexpr int C_SSQ = 3 * 8192;
constexpr int C_SSKV = 5 * 8192;
constexpr int C_SSA = 7 * 8192, C_SSB = 9 * 8192, C_SSC = 11 * 8192;
constexpr int C_CNT = 13 * 8192;

constexpr int RING_BYTES = 131072, XPOSE_OFF = RING_BYTES + 256, LDS_BYTES = XPOSE_OFF + 8192;

DI unsigned pk2(float lo, float hi) { f32x2_t v = {lo, hi}; bf16x2_t b = __builtin_convertvector(v, bf16x2_t); return __builtin_bit_cast(unsigned, b); }
DI bf16_t f2bf(float f) { return (bf16_t)(pk2(f, 0.f) & 0xffffu); }
DI float bflo(unsigned w) { return __builtin_bit_cast(float, w << 16); }
DI float bfhi(unsigned w) { return __builtin_bit_cast(float, w & 0xffff0000u); }
DI float bf2f(bf16_t u) { return __builtin_bit_cast(float, (unsigned)u << 16); }
DI float ex2(float x) { return __builtin_amdgcn_exp2f(x); }
DI float lg2(float x) { return __builtin_amdgcn_logf(x); }
DI float rcpf(float x) { return __builtin_amdgcn_rcpf(x); }
DI float silu(float z) { return z * rcpf(1.f + ex2(-z * LOG2E)); }
DI float gelu_tanh(float x) { const float u = 0.7978845608028654f * (x + 0.044715f * x * x * x); return x * rcpf(1.f + ex2(-2.f * LOG2E * u)); }
DI float wave_sum(float v) {
#pragma unroll
    for (int o = 1; o < 64; o <<= 1) v += __shfl_xor(v, o);
    return v;
}
DI void atomic_addf(float* p, float v) { __hip_atomic_fetch_add(p, v, __ATOMIC_RELAXED, __HIP_MEMORY_SCOPE_AGENT); }
#define LDS_WAIT() asm volatile("s_waitcnt lgkmcnt(0)" ::: "memory")

namespace pg8 {
constexpr int BM = 256, BK = 64, HALF = 128, HTB = HALF * BK * 2, STAGE_BYTES = 8 * HTB, NXCD = 8, WGM = 8;
DI int lds_byte(int r, int c) { const int st = (r >> 4) * 2 + (c >> 5), rr = r & 15, cc = c & 31, ob = rr * 64 + cc * 2; return st * 1024 + (ob ^ (((ob >> 9) & 1) << 5)); }
DI void stage_rc(int b, int& R, int& C) { const int st = b / 1024, sb = b % 1024, swz = sb ^ (((sb >> 9) & 1) << 5); R = (st >> 1) * 16 + swz / 64; C = (st & 1) * 32 + (swz % 64) / 2; }
DI int perm32(int rho) { const int n = rho >> 4, i = rho & 15; return 8 * (i >> 2) + 4 * n + (i & 3); }

struct Unit { int pm, pn; };
struct Gemm { const bf16_t* A; const bf16_t* Bt; int lda, ldb, K, M, N; };

struct StaticOrder {
    int nM, nN, nwg, G, c;
    DI void init(int M, int N, int G_, int c_) { nM = M / BM; nN = N / BM; nwg = nM * nN; G = G_; c = c_; }
    DI bool next(int i, Unit& u) const {
        const long L = (long)i * G + c; if (L >= nwg) return false;
        int wgid = (int)L; { const int q = nwg / NXCD, r = nwg % NXCD, xcd = wgid % NXCD, off = wgid / NXCD; wgid = (xcd < r ? xcd * (q + 1) : r * (q + 1) + (xcd - r) * q) + off; }
        const int nig = WGM * nN, gid = wgid / nig, fm = gid * WGM, gsz = (nM - fm) < WGM ? (nM - fm) : WGM;
        u.pm = fm + ((wgid % nig) % gsz); u.pn = (wgid % nig) / gsz; return true;
    }
};

template <class Epi, bool ALIGN_EPI = true>
DI void gemm_phase(const int tid, LAS unsigned char* lds, const Gemm g, const StaticOrder& S, const Epi& E) {
    const int wid = __builtin_amdgcn_readfirstlane(tid >> 6), lane = tid & 63, wr = wid >> 2, wc = wid & 3, fr = lane & 15, fq = lane >> 4;
    const int K = g.K, nt = K / BK;
    unsigned voffA[2], voffB[2];
#pragma unroll
    for (int i = 0; i < 2; ++i) { int R, C; stage_rc(tid * 16 + i * 8192, R, C); const int Rb = (R & ~31) + perm32(R & 31);
        voffA[i] = (unsigned)(R * g.lda + C) * 2u; voffB[i] = (unsigned)(Rb * g.ldb + C) * 2u; }
    const size_t kstep = (size_t)(BK * 2);
    const size_t hstepA = (size_t)HALF * g.lda * 2, hstepB = (size_t)HALF * g.ldb * 2;
    const size_t tstepA = 2 * hstepA, tstepB = 2 * hstepB;
    const unsigned ldsw = (unsigned)wid * 1024u;
    const int aoff = lds_byte(wr * 64 + fr, fq * 8), boff = lds_byte(wc * 32 + fr, fq * 8);
#define PG8_SA(b, h) (((b) * 2 + (h)) * HTB)
#define PG8_SB(b, h) ((4 + (b) * 2 + (h)) * HTB)
#define PG8_STAGE(bufoff, gbase, voff) do { _Pragma("unroll") for (int _i = 0; _i < 2; ++_i) \
        __builtin_amdgcn_global_load_lds((const unsigned*)((const char*)(gbase) + (voff)[_i]), (LAS unsigned*)(lds + (bufoff) + ldsw + _i * 8192), 16, 0, 0); } while (0)
#define PG8_LDA(dst, b, h) do { _Pragma("unroll") for (int m = 0; m < 4; ++m) _Pragma("unroll") for (int k = 0; k < 2; ++k) dst[m][k] = *(const LAS bf16x8*)(lds + PG8_SA(b, h) + aoff + m * 2048 + k * 1024); } while (0)
#define PG8_LDB(dst, b, h) do { _Pragma("unroll") for (int n = 0; n < 2; ++n) _Pragma("unroll") for (int k = 0; k < 2; ++k) dst[n][k] = *(const LAS bf16x8*)(lds + PG8_SB(b, h) + boff + n * 2048 + k * 1024); } while (0)
#define PG8_MMA(ai, bj, At, Bt) do { __builtin_amdgcn_s_setprio(1); _Pragma("unroll") for (int m = 0; m < 4; ++m) _Pragma("unroll") for (int n = 0; n < 2; ++n) _Pragma("unroll") for (int k = 0; k < 2; ++k) \
        acc[ai][bj][m][n] = __builtin_amdgcn_mfma_f32_16x16x32_bf16(Bt[n][k], At[m][k], acc[ai][bj][m][n], 0, 0, 0); __builtin_amdgcn_s_setprio(0); } while (0)
#define PG8_WAIT_V(n) asm volatile("s_waitcnt vmcnt(" #n ")" ::: "memory")
#define PG8_WAIT_L(n) asm volatile("s_waitcnt lgkmcnt(" #n ")" ::: "memory")
#define PG8_BAR __builtin_amdgcn_s_barrier()
#define PG8_SCHED __builtin_amdgcn_sched_barrier(0)
    Unit cur, nxt; int ui = 0;
    if (!S.next(0, cur)) return;
    f32x4 acc[2][2][4][2];
#pragma unroll
    for (int a = 0; a < 2; ++a)
#pragma unroll
        for (int b = 0; b < 2; ++b)
#pragma unroll
            for (int m = 0; m < 4; ++m)
#pragma unroll
                for (int n = 0; n < 2; ++n) acc[a][b][m][n] = (f32x4){0.f, 0.f, 0.f, 0.f};
    bf16x8 At[4][2], B0[2][2], B1[2][2];
    const char* cA = (const char*)g.A + (size_t)cur.pm * tstepA; const char* cB = (const char*)g.Bt + (size_t)cur.pn * tstepB;
    PG8_STAGE(PG8_SB(0, 0), cB, voffB); PG8_STAGE(PG8_SB(0, 1), cB + hstepB, voffB); PG8_STAGE(PG8_SA(0, 0), cA, voffA); PG8_STAGE(PG8_SA(0, 1), cA + hstepA, voffA);
    if (wr == 1) PG8_BAR;
    PG8_WAIT_V(2); PG8_BAR;
    PG8_STAGE(PG8_SB(1, 0), cB + kstep, voffB); PG8_STAGE(PG8_SA(1, 0), cA + kstep, voffA); PG8_STAGE(PG8_SB(1, 1), cB + hstepB + kstep, voffB);
    PG8_WAIT_V(6); PG8_BAR;
    if constexpr (Epi::KSCALE) E.preload(cur, tid);
    for (;;) {
        const bool has_next = S.next(ui + 1, nxt);
        const char* nA = has_next ? (const char*)g.A + (size_t)nxt.pm * tstepA : cA; const char* nB = has_next ? (const char*)g.Bt + (size_t)nxt.pn * tstepB : cB;
        for (int t = 0; t < nt; t += 2) {
            const bool last = (t == nt - 2);
            const char* a1 = cA + (size_t)(t + 1) * kstep;
            const char* a2 = last ? nA : cA + (size_t)(t + 2) * kstep; const char* b2 = last ? nB : cB + (size_t)(t + 2) * kstep;
            const char* a3 = a2 + kstep; const char* b3 = b2 + kstep;
            if constexpr (Epi::KSCALE) { if (t == Epi::KS1 || t == Epi::KS2) E.kscale(acc, cur, t, wr, fr); }
            PG8_LDB(B0, 0, 0); PG8_LDB(B1, 0, 1); PG8_SCHED; PG8_LDA(At, 0, 0); PG8_STAGE(PG8_SA(1, 1), a1 + hstepA, voffA);
            PG8_WAIT_V(8); PG8_WAIT_L(0); PG8_BAR; PG8_MMA(0, 0, At, B0); PG8_MMA(0, 1, At, B1); PG8_BAR; PG8_SCHED;
            PG8_LDA(At, 0, 1); PG8_STAGE(PG8_SB(0, 0), b2, voffB); PG8_STAGE(PG8_SB(0, 1), b2 + hstepB, voffB); PG8_STAGE(PG8_SA(0, 0), a2, voffA);
            PG8_WAIT_V(8); PG8_WAIT_L(0); PG8_BAR; PG8_MMA(1, 0, At, B0); PG8_MMA(1, 1, At, B1); PG8_BAR; PG8_SCHED;
            PG8_LDB(B0, 1, 0); PG8_LDB(B1, 1, 1); PG8_SCHED; PG8_LDA(At, 1, 0); PG8_STAGE(PG8_SA(0, 1), a2 + hstepA, voffA);
            PG8_WAIT_V(8); PG8_WAIT_L(0); PG8_BAR; PG8_MMA(0, 0, At, B0); PG8_MMA(0, 1, At, B1); PG8_BAR; PG8_SCHED;
            PG8_LDA(At, 1, 1); PG8_STAGE(PG8_SB(1, 0), b3, voffB); PG8_STAGE(PG8_SB(1, 1), b3 + hstepB, voffB); PG8_STAGE(PG8_SA(1, 0), a3, voffA);
            PG8_WAIT_V(8); PG8_WAIT_L(0); PG8_BAR; PG8_MMA(1, 0, At, B0); PG8_MMA(1, 1, At, B1); PG8_BAR; PG8_SCHED;
        }
        if constexpr (ALIGN_EPI) { if (wr == 0) PG8_BAR; }
        E(acc, cur, wr, wc, fr, fq);
        if (!has_next) break;
#pragma unroll
        for (int a = 0; a < 2; ++a)
#pragma unroll
            for (int b = 0; b < 2; ++b)
#pragma unroll
                for (int m = 0; m < 4; ++m)
#pragma unroll
                    for (int n = 0; n < 2; ++n) acc[a][b][m][n] = (f32x4){0.f, 0.f, 0.f, 0.f};
        cur = nxt; cA = nA; cB = nB; ++ui;
        if constexpr (Epi::KSCALE) E.preload(cur, tid);
        if constexpr (ALIGN_EPI) { if (wr == 1) PG8_BAR; }
    }
    PG8_WAIT_V(0);
    if constexpr (!ALIGN_EPI) { if (wr == 0) PG8_BAR; }
    PG8_BAR;
#undef PG8_SA
#undef PG8_SB
#undef PG8_STAGE
#undef PG8_LDA
#undef PG8_LDB
#undef PG8_MMA
#undef PG8_WAIT_V
#undef PG8_WAIT_L
#undef PG8_BAR
#undef PG8_SCHED
}
}

typedef f32x4 acc_t[2][2][4][2];

DI void store8_bf16(bf16_t* p, f32x4 v0, f32x4 v1) {
    u32x4 w; w.x = pk2(v0[0], v0[1]); w.y = pk2(v0[2], v0[3]); w.z = pk2(v1[0], v1[1]); w.w = pk2(v1[2], v1[3]);
    *(u32x4*)p = w;
}
DI size_t vt_index(int bh, int s, int d) { return ((size_t)(bh * 256 + (s >> 4)) * 128 + d) * 16 + (s & 15); }
DI void store_T_wave(LAS unsigned char* scr, bf16_t* vt0, int fr, int fq, int lane, f32x4 v0, f32x4 v1) {
    LAS bf16_t* w = (LAS bf16_t*)(scr + (8 * fq) * 32 + fr * 2);
    w[0 * 16] = f2bf(v0[0]); w[1 * 16] = f2bf(v0[1]); w[2 * 16] = f2bf(v0[2]); w[3 * 16] = f2bf(v0[3]);
    w[4 * 16] = f2bf(v1[0]); w[5 * 16] = f2bf(v1[1]); w[6 * 16] = f2bf(v1[2]); w[7 * 16] = f2bf(v1[3]);
    const u32x4 c = *(const LAS u32x4*)(scr + lane * 16);
    *(u32x4*)(vt0 + lane * 8) = c;
}
DI float sumsq8(f32x4 a, f32x4 b) { return (a[0] * a[0] + a[1] * a[1]) + (a[2] * a[2] + a[3] * a[3]) + (b[0] * b[0] + b[1] * b[1]) + (b[2] * b[2] + b[3] * b[3]); }

struct EpiInProj {
    static constexpr bool KSCALE = false; static constexpr int KS1 = -1, KS2 = -1;
    bf16_t* proj; bf16_t* vbt; const float* ssx; float* ssq; float* sskv; bool accum; LAS unsigned char* scr;
    DI void kscale(acc_t&, const pg8::Unit&, int, int, int) const {}
    DI void operator()(const acc_t& acc, const pg8::Unit& u, int wr, int wc, int fr, int fq) const {
        const int pn = u.pn;
        const int row0 = u.pm * 256 + wr * 64 + fr, colb = pn * 256 + wc * 32 + 8 * fq;
        const bool isq = (pn >= 12 && pn < 18), isv = (pn >= 24 && pn < 30), isn = (pn >= 36 && pn < 41);
        float ssv[2][4];
#pragma unroll
        for (int ai = 0; ai < 2; ++ai)
#pragma unroll
            for (int m = 0; m < 4; ++m) ssv[ai][m] = ssx[row0 + ai * 128 + m * 16];
#pragma unroll
        for (int ai = 0; ai < 2; ++ai)
#pragma unroll
            for (int m = 0; m < 4; ++m) {
                const int row = row0 + ai * 128 + m * 16;
                float rs = rsqrtf(ssv[ai][m] * (1.f / 4096.f) + EPS);
                if (isq) rs *= QSB;
                float sq = 0.f;
#pragma unroll
                for (int bj = 0; bj < 2; ++bj) {
                    const int col = colb + bj * 128;
                    const f32x4 v0 = acc[ai][bj][m][0] * rs, v1 = acc[ai][bj][m][1] * rs;
                    if (isv) {
                        const int head = 2 * (pn - 24) + bj, b = row >> 12, s0 = (row & 4095) & ~15;
                        store_T_wave(scr, vbt + vt_index(b * NHEAD + head, s0, wc * 32), fr, fq, fq * 16 + fr, v0, v1);
                    } else if (col < DIN) {
                        store8_bf16(proj + (size_t)row * DINP + col, v0, v1);
                    }
                    sq += sumsq8(v0, v1);
                }
                if (isn && accum) {
                    sq += __shfl_xor(sq, 16); sq += __shfl_xor(sq, 32);
                    if (fq == 0) atomic_addf((pn < 39 ? ssq : sskv) + row, sq);
                }
            }
    }
};

struct EpiUQ {
    static constexpr bool KSCALE = false; static constexpr int KS1 = -1, KS2 = -1;
    bf16_t* qc; const float* ssq;
    DI void kscale(acc_t&, const pg8::Unit&, int, int, int) const {}
    DI void operator()(const acc_t& acc, const pg8::Unit& u, int wr, int wc, int fr, int fq) const {
        const int row0 = u.pm * 256 + wr * 64 + fr, colb = u.pn * 256 + wc * 32 + 8 * fq;
        float ssv[2][4];
#pragma unroll
        for (int ai = 0; ai < 2; ++ai)
#pragma unroll
            for (int m = 0; m < 4; ++m) ssv[ai][m] = ssq[row0 + ai * 128 + m * 16];
#pragma unroll
        for (int ai = 0; ai < 2; ++ai)
#pragma unroll
            for (int m = 0; m < 4; ++m) {
                const int row = row0 + ai * 128 + m * 16;
                const float rs = rsqrtf(ssv[ai][m] * (1.f / 768.f) + EPS) * QSC;
#pragma unroll
                for (int bj = 0; bj < 2; ++bj)
                    store8_bf16(qc + (size_t)row * NUQ + colb + bj * 128, acc[ai][bj][m][0] * rs, acc[ai][bj][m][1] * rs);
            }
    }
};

struct EpiUKV {
    static constexpr bool KSCALE = false; static constexpr int KS1 = -1, KS2 = -1;
    bf16_t* kc; bf16_t* vct; const float* sskv; LAS unsigned char* scr;
    DI void kscale(acc_t&, const pg8::Unit&, int, int, int) const {}
    DI void operator()(const acc_t& acc, const pg8::Unit& u, int wr, int wc, int fr, int fq) const {
        const int row0 = u.pm * 256 + wr * 64 + fr, head = u.pn, d0 = wc * 32 + 8 * fq;
        float ssv[2][4];
#pragma unroll
        for (int ai = 0; ai < 2; ++ai)
#pragma unroll
            for (int m = 0; m < 4; ++m) ssv[ai][m] = sskv[row0 + ai * 128 + m * 16];
#pragma unroll
        for (int ai = 0; ai < 2; ++ai)
#pragma unroll
            for (int m = 0; m < 4; ++m) {
                const int row = row0 + ai * 128 + m * 16;
                const float rs = rsqrtf(ssv[ai][m] * (1.f / 512.f) + EPS);
                store8_bf16(kc + (size_t)row * NUQ + head * 192 + d0, acc[ai][0][m][0] * rs, acc[ai][0][m][1] * rs);
                const int b = row >> 12, s0 = (row & 4095) & ~15;
                store_T_wave(scr, vct + vt_index(b * NHEAD + head, s0, wc * 32), fr, fq, fq * 16 + fr, acc[ai][1][m][0] * rs, acc[ai][1][m][1] * rs);
            }
    }
};

struct EpiOut {
    static constexpr bool KSCALE = true; static constexpr int KS1 = 16, KS2 = 40;
    const bf16_t* xin; float* xout; bf16_t* xb; float* ssn; const float *ssa, *ssb, *ssc; bool accum;
    LAS float* fac;
    DI void preload(const pg8::Unit& u, int tid) const {
        const int rl = tid & 255, which = tid >> 8, row = u.pm * 256 + rl;
        const float va = ssa[row], vb = ssb[row], vc = ssc[row];
        const float rb = rsqrtf(vb * (1.f / 1536.f) + EPS);
        fac[which * 256 + rl] = which == 0 ? rsqrtf(va * (1.f / 1024.f) + EPS) / rb : rb / rsqrtf(vc * (1.f / 1536.f) + EPS);
    }
    DI void kscale(acc_t& acc, const pg8::Unit& u, int t, int wr, int fr) const {
        const LAS float* fp = fac + (t == KS1 ? 0 : 256) + wr * 64 + fr;
#pragma unroll
        for (int ai = 0; ai < 2; ++ai)
#pragma unroll
            for (int m = 0; m < 4; ++m) {
                const float f = fp[ai * 128 + m * 16];
#pragma unroll
                for (int bj = 0; bj < 2; ++bj)
#pragma unroll
                    for (int n = 0; n < 2; ++n) acc[ai][bj][m][n] *= f;
            }
    }
    DI void operator()(const acc_t& acc, const pg8::Unit& u, int wr, int wc, int fr, int fq) const {
        const int row0 = u.pm * 256 + wr * 64 + fr, colb = u.pn * 256 + wc * 32 + 8 * fq;
#pragma unroll
        for (int ai = 0; ai < 2; ++ai) {
            u32x4 xw[4][2]; float sv[4];
#pragma unroll
            for (int m = 0; m < 4; ++m) { const int row = row0 + ai * 128 + m * 16; sv[m] = ssc[row];
#pragma unroll
                for (int bj = 0; bj < 2; ++bj) xw[m][bj] = *(const u32x4*)(xin + (size_t)row * DM + colb + bj * 128); }
#pragma unroll
            for (int m = 0; m < 4; ++m) {
                const int row = row0 + ai * 128 + m * 16;
                const float rc = rsqrtf(sv[m] * (1.f / 1536.f) + EPS);
                float sq = 0.f;
#pragma unroll
                for (int bj = 0; bj < 2; ++bj) {
                    const size_t o = (size_t)row * DM + colb + bj * 128;
                    const u32x4 w = xw[m][bj];
                    const f32x4 x0 = {bflo(w.x), bfhi(w.x), bflo(w.y), bfhi(w.y)}, x1 = {bflo(w.z), bfhi(w.z), bflo(w.w), bfhi(w.w)};
                    const f32x4 o0 = x0 + acc[ai][bj][m][0] * rc, o1 = x1 + acc[ai][bj][m][1] * rc;
                    if (xout) { *(f32x4*)(xout + o) = o0; *(f32x4*)(xout + o + 4) = o1; }
                    if (xb) store8_bf16(xb + o, o0, o1);
                    sq += sumsq8(o0, o1);
                }
                sq += __shfl_xor(sq, 16); sq += __shfl_xor(sq, 32);
                if (fq == 0 && accum) atomic_addf(ssn + row, sq);
            }
        }
    }
};

struct Args { const float* in[14]; float* out; unsigned char* ws; int ph_lo, ph_hi; };
struct Ptrs {
    const float *x, *g_pre, *w_in, *a_g_v, *a_w_s, *a_b_s, *c_g_q, *c_g_kv, *c_w_uq, *c_w_ukv, *g_out, *w_out, *g_final; const int* pos;
    float* out; float* ctl; unsigned* cnt;
    bf16_t *win, *wout, *wuq, *wukv, *xb, *proj, *vbt, *qc, *kc, *vct, *yg; float *cosT, *sinT;
};

DI void p0_transpose_item(const float* W, const float* gk, int K, int N, bf16_t* WT, LAS float* scr, int item, int lane) {
    const int nblk = N / 32, kb = item / nblk, nb = item % nblk, k0 = 64 * kb, n0 = 32 * nb;
#pragma unroll 8
    for (int i = 0; i < 32; ++i) { const int kk = 2 * i + (lane >> 5); scr[kk * 33 + (lane & 31)] = W[(size_t)(k0 + kk) * N + n0 + (lane & 31)] * gk[k0 + kk]; }
    LDS_WAIT();
    const int c = lane & 7;
#pragma unroll
    for (int j = 0; j < 4; ++j) { const int n = (lane >> 3) + 8 * j; const LAS float* s = scr + (8 * c) * 33 + n;
        u32x4 o; o.x = pk2(s[0 * 33], s[1 * 33]); o.y = pk2(s[2 * 33], s[3 * 33]); o.z = pk2(s[4 * 33], s[5 * 33]); o.w = pk2(s[6 * 33], s[7 * 33]);
        *(u32x4*)(WT + (size_t)(n0 + n) * K + k0 + 8 * c) = o; }
    LDS_WAIT();
}

DI void phase0(const int tid, LAS unsigned char* lds, const Ptrs& P) {
    const int lane = tid & 63, wave = tid >> 6, G = gridDim.x;
    const int gw = blockIdx.x * 8 + wave, NGW = G * 8;
    LAS float* scr = (LAS float*)(lds + wave * 8448);
    constexpr int I_IN = (DM / 64) * (DIN / 32), I_OUT = (DM / 64) * (DM / 32), I_UQ = (QL / 64) * (NUQ / 32), I_UKV = (KVL / 64) * (NUKV / 32);
    constexpr int I_L = I_IN + I_OUT + I_UQ + I_UKV;
    for (int it = gw; it < 2 * I_L; it += NGW) {
        const int l = it / I_L; int r = it % I_L;
        if (r < I_IN) { p0_transpose_item(P.w_in + (size_t)l * DM * DIN, P.g_pre + l * DM, DM, DIN, P.win + (size_t)l * DINP * DM, scr, r, lane); continue; } r -= I_IN;
        if (r < I_OUT) { p0_transpose_item(P.w_out + (size_t)l * DM * DM, P.g_out + l * DM, DM, DM, P.wout + (size_t)l * DM * DM, scr, r, lane); continue; } r -= I_OUT;
        if (r < I_UQ) { p0_transpose_item(P.c_w_uq + (size_t)l * QL * NUQ, P.c_g_q + l * QL, QL, NUQ, P.wuq + (size_t)l * NUQ * QL, scr, r, lane); continue; } r -= I_UQ;
        p0_transpose_item(P.c_w_ukv + (size_t)l * KVL * NUKV, P.c_g_kv + l * KVL, KVL, NUKV, P.wukv + (size_t)l * NUKV * KVL, scr, r, lane);
    }
    for (int row = gw; row < M_TOK; row += NGW) {
        const f32x4* xr = (const f32x4*)(P.x + (size_t)row * DM) + lane;
        u32x2* o8 = (u32x2*)(P.xb + (size_t)row * DM) + lane;
        float s = 0.f;
        f32x4 xv[16];
#pragma unroll
        for (int j = 0; j < 16; ++j) xv[j] = xr[64 * j];
#pragma unroll
        for (int j = 0; j < 16; ++j) { const f32x4 v = xv[j]; s += (v[0] * v[0] + v[1] * v[1]) + (v[2] * v[2] + v[3] * v[3]);
            u32x2 w; w.x = pk2(v[0], v[1]); w.y = pk2(v[2], v[3]); o8[64 * j] = w; }
        s = wave_sum(s);
        if (lane == 0) P.ctl[C_SSX + row] = s;
    }
    for (int idx = blockIdx.x * 512 + tid; idx < M_TOK * 32; idx += G * 512) {
        const int row = idx >> 5, i = idx & 31;
        const float inv = ex2(-(float)i * 0.41524101186092029f);
        const float ang = (float)P.pos[row] * inv;
        const float nrev = rintf(ang * 0.15915494309189535f);
        float rr = fmaf(-nrev, 6.2831854820251465f, ang); rr = fmaf(-nrev, -1.7484555e-7f, rr);
        const float xf = rr * 0.15915494309189535f;
        P.cosT[idx] = __builtin_amdgcn_cosf(xf); P.sinT[idx] = __builtin_amdgcn_sinf(xf);
    }
}

DI void rope_kr(const int tid, const Ptrs& P) {
    for (int idx = blockIdx.x * 512 + tid; idx < M_TOK * 32; idx += gridDim.x * 512) {
        const int row = idx >> 5, i = idx & 31;
        const float x1 = bf2f(P.proj[(size_t)row * DINP + OFF_KR + i]), x2 = bf2f(P.proj[(size_t)row * DINP + OFF_KR + 32 + i]);
        const float c = P.cosT[idx], s = P.sinT[idx];
        const bf16_t o1 = f2bf(x1 * c - x2 * s), o2 = f2bf(x2 * c + x1 * s);
        bf16_t* dst = P.kc + (size_t)row * NUQ + 128 + i;
#pragma unroll
        for (int hd = 0; hd < NHEAD; ++hd) { dst[hd * 192] = o1; dst[hd * 192 + 32] = o2; }
    }
}

DI int crow(int i, int h) { return (i & 3) + 8 * (i >> 2) + 4 * h; }

DI void gmlp_item(const int tid, LAS unsigned char* lds, int item, const Ptrs& P, int l, bool accum = true) {
    const int wid = tid >> 6, lane = tid & 63;
    const int bc = item >> 3, g = item & 7, row0 = bc * 128;
    LAS unsigned char* Wl = lds; LAS unsigned char* Vt = lds + 128 * 272;
    const int ti = wid >> 1, djb = (wid & 1) * 2, r = lane & 31, h = lane >> 5;
    const int s = tid >> 2, d0 = (tid & 3) * 32;
    const bf16_t* vsrc = P.proj + (size_t)(row0 + s) * DINP + OFF_VA + g * 128 + d0;
    const float* wsrc = P.a_w_s + ((size_t)(l * 8 + g) * 128 + s) * 128 + d0;
    const float* gsrc = P.a_g_v + (l * 8 + g) * 128 + d0;
    u32x4 vw[4]; f32x4 ww[8], gw[8];
#pragma unroll
    for (int c = 0; c < 4; ++c) vw[c] = *(const u32x4*)(vsrc + 8 * c);
#pragma unroll
    for (int c = 0; c < 8; ++c) { ww[c] = *(const f32x4*)(wsrc + 4 * c); gw[c] = *(const f32x4*)(gsrc + 4 * c); }
    const int t = 32 * ti + r, row = row0 + t;
    const float bias = P.a_b_s[(l * 8 + g) * 128 + t];
    const bf16_t* up = P.proj + (size_t)row * DINP + OFF_UA + g * 128 + 32 * djb + 4 * h;
    const bf16_t* zp = P.proj + (size_t)row * DINP + OFF_ZA + g * 128 + 32 * djb + 4 * h;
    bf16_t* yp = P.yg + (size_t)row * DM + g * 128 + 32 * djb + 4 * h;
    u32x2 uv[2][4], zv[2][4];
#pragma unroll
    for (int jj = 0; jj < 2; ++jj)
#pragma unroll
        for (int g4 = 0; g4 < 4; ++g4) { uv[jj][g4] = *(const u32x2*)(up + 32 * jj + 8 * g4); zv[jj][g4] = *(const u32x2*)(zp + 32 * jj + 8 * g4); }
    {
        float v[32]; float ss = 0.f;
#pragma unroll
        for (int c = 0; c < 4; ++c)
#pragma unroll
            for (int k = 0; k < 4; ++k) { const float a = gelu_tanh(bflo(vw[c][k])), b = gelu_tanh(bfhi(vw[c][k])); v[8 * c + 2 * k] = a; v[8 * c + 2 * k + 1] = b; ss += a * a + b * b; }
        ss += __shfl_xor(ss, 1); ss += __shfl_xor(ss, 2);
        const float rs = rsqrtf(ss * (1.f / 128.f) + EPS);
#pragma unroll
        for (int j = 0; j < 32; ++j) *(LAS bf16_t*)(Vt + (d0 + j) * 272 + s * 2) = f2bf(v[j] * rs * gw[j >> 2][j & 3]);
    }
    {
#pragma unroll
        for (int c = 0; c < 4; ++c) { f32x4 a = ww[2 * c], b = ww[2 * c + 1];
#pragma unroll
            for (int k = 0; k < 4; ++k) { if (d0 + 8 * c + k > s) a[k] = 0.f; if (d0 + 8 * c + 4 + k > s) b[k] = 0.f; }
            u32x4 w; w.x = pk2(a[0], a[1]); w.y = pk2(a[2], a[3]); w.z = pk2(b[0], b[1]); w.w = pk2(b[2], b[3]);
            *(LAS u32x4*)(Wl + s * 272 + (d0 + 8 * c) * 2) = w; }
    }
    __syncthreads();
    f32x16 D[2];
#pragma unroll
    for (int i = 0; i < 16; ++i) { D[0][i] = 0.f; D[1][i] = 0.f; }
#pragma unroll
    for (int st = 0; st < 8; ++st) {
        const bf16x8 af = *(const LAS bf16x8*)(Wl + (32 * ti + r) * 272 + (16 * st + 8 * h) * 2);
#pragma unroll
        for (int jj = 0; jj < 2; ++jj) { const bf16x8 bfr = *(const LAS bf16x8*)(Vt + (32 * (djb + jj) + r) * 272 + (16 * st + 8 * h) * 2);
            D[jj] = __builtin_amdgcn_mfma_f32_32x32x16_bf16(bfr, af, D[jj], 0, 0, 0); }
    }
    float sq = 0.f;
#pragma unroll
    for (int jj = 0; jj < 2; ++jj)
#pragma unroll
        for (int g4 = 0; g4 < 4; ++g4) {
            const u32x2 uu = uv[jj][g4], zz = zv[jj][g4];
            const float y0 = gelu_tanh(bflo(uu.x)) * (D[jj][4 * g4 + 0] + bias), y1 = gelu_tanh(bfhi(uu.x)) * (D[jj][4 * g4 + 1] + bias);
            const float y2 = gelu_tanh(bflo(uu.y)) * (D[jj][4 * g4 + 2] + bias), y3 = gelu_tanh(bfhi(uu.y)) * (D[jj][4 * g4 + 3] + bias);
            sq += (y0 * y0 + y1 * y1) + (y2 * y2 + y3 * y3);
            u32x2 o; o.x = pk2(y0 * silu(bflo(zz.x)), y1 * silu(bfhi(zz.x))); o.y = pk2(y2 * silu(bflo(zz.y)), y3 * silu(bfhi(zz.y)));
            *(u32x2*)(yp + 32 * jj + 8 * g4) = o;
        }
    sq += __shfl_xor(sq, 32);
    if (h == 0 && accum) atomic_addf(P.ctl + C_SSA + l * M_TOK + row, sq);
    __syncthreads();
}

template <int TYPE>
DI void attn_item(const int tid, LAS unsigned char* lds, int bh, int qb, const Ptrs& P, int l, bool accum = true) {
    constexpr int DQK = TYPE == 0 ? 192 : 128, NT = DQK / 16, KSTR = DQK * 2 + 16, VSTR = 144, KBUF = 64 * KSTR, VBUF = 128 * VSTR, BUFB = KBUF + VBUF;
    const int wid = __builtin_amdgcn_readfirstlane(tid >> 6), lane = tid & 63, r = lane & 31, h = lane >> 5;
    const int b = bh / NHEAD, head = bh % NHEAD;
    const int qrow = qb * 256 + 32 * wid + r, grow = b * SEQ + qrow;
    const int pr = (r & ~12) | ((r & 4) << 1) | ((r & 8) >> 1);

    constexpr int CPR_K = DQK / 8 + 1, NKP = CPR_K, NKI = (NKP + 7) / 8, NVP = 18, NVI = 3;
    constexpr int KLD = TYPE == 1 ? DINP : NUQ;
    const char* kbase = TYPE == 1 ? (const char*)(P.proj + (size_t)(b * SEQ) * DINP + OFF_KB + head * 128) : (const char*)(P.kc + (size_t)(b * SEQ) * NUQ + head * 192);
    const char* vbase = (const char*)((TYPE == 1 ? P.vbt : P.vct) + (size_t)bh * 128 * SEQ);
    unsigned koff[NKI], voff[NVI];
#pragma unroll
    for (int i = 0; i < NKI; ++i) { const int c = tid + 512 * i, row = c / CPR_K; int part = c - row * CPR_K; part = part > CPR_K - 2 ? CPR_K - 2 : part; koff[i] = (unsigned)(row * (KLD * 2) + part * 16); }
#pragma unroll
    for (int i = 0; i < NVI; ++i) { const int c = tid + 512 * i, d = c / 9; int part = c - d * 9; part = part > 7 ? 7 : part; voff[i] = (unsigned)((((part >> 1) * 128 + d) * 16 + (part & 1) * 8) * 2); }

    const int ntiles = 4 * (qb + 1), jd = 4 * qb + (wid >> 1);
#define ATT_DMA(jt, buf) do { const char* _kb = kbase + (size_t)(jt) * (64 * KLD * 2); const char* _vb = vbase + (size_t)(jt) * 16384; \
        _Pragma("unroll") for (int _i = 0; _i < NKI; ++_i) if (wid + 8 * _i < NKP) \
            __builtin_amdgcn_global_load_lds((const unsigned*)(_kb + koff[_i]), (LAS unsigned*)((buf) + (wid + 8 * _i) * 1024), 16, 0, 0); \
        _Pragma("unroll") for (int _i = 0; _i < NVI; ++_i) if (wid + 8 * _i < NVP) \
            __builtin_amdgcn_global_load_lds((const unsigned*)(_vb + voff[_i]), (LAS unsigned*)((buf) + KBUF + (wid + 8 * _i) * 1024), 16, 0, 0); } while (0)
#define ATT_WAIT() asm volatile("s_waitcnt vmcnt(0)" ::: "memory")
    ATT_DMA(ntiles - 1, lds);
    bf16x8 qf[NT];
    if constexpr (TYPE == 1) {
        const bf16_t* qp = P.proj + (size_t)grow * DINP + OFF_QB + head * 128 + 8 * h;
#pragma unroll
        for (int t = 0; t < NT; ++t) qf[t] = *(const bf16x8*)(qp + 16 * t);
    } else {
        const bf16_t* qp = P.qc + (size_t)grow * NUQ + head * 192 + 8 * h;
#pragma unroll
        for (int t = 0; t < NT; ++t) qf[t] = *(const bf16x8*)(qp + 16 * t);
#pragma unroll
        for (int tt = 0; tt < 2; ++tt) {
            const float* cp = P.cosT + grow * 32 + 16 * tt + 8 * h; const float* sp = P.sinT + grow * 32 + 16 * tt + 8 * h;
            const f32x4 c0 = *(const f32x4*)cp, c1 = *(const f32x4*)(cp + 4), s0 = *(const f32x4*)sp, s1 = *(const f32x4*)(sp + 4);
            const u32x4 a = __builtin_bit_cast(u32x4, qf[8 + tt]), bb = __builtin_bit_cast(u32x4, qf[10 + tt]);
            u32x4 o1, o2;
#pragma unroll
            for (int k = 0; k < 4; ++k) {
                const float cl = k < 2 ? c0[2 * k] : c1[2 * k - 4], ch = k < 2 ? c0[2 * k + 1] : c1[2 * k - 3];
                const float sl = k < 2 ? s0[2 * k] : s1[2 * k - 4], sh = k < 2 ? s0[2 * k + 1] : s1[2 * k - 3];
                const float x1l = bflo(a[k]), x1h = bfhi(a[k]), x2l = bflo(bb[k]), x2h = bfhi(bb[k]);
                o1[k] = pk2(x1l * cl - x2l * sl, x1h * ch - x2h * sh);
                o2[k] = pk2(x2l * cl + x1l * sl, x2h * ch + x1h * sh);
            }
            qf[8 + tt] = __builtin_bit_cast(bf16x8, o1); qf[10 + tt] = __builtin_bit_cast(bf16x8, o2);
        }
    }

    f32x16 O[4];
#pragma unroll
    for (int d = 0; d < 4; ++d)
#pragma unroll
        for (int i = 0; i < 16; ++i) O[d][i] = 0.f;
    float m_run = -INFINITY, l_run = 0.f, carry = (TYPE == 1) ? 1.f : 0.f;

    ATT_WAIT(); __syncthreads();
    for (int it = 0; it < ntiles; ++it) {
        const int jt = ntiles - 1 - it;
        LAS unsigned char* cur = lds + (it & 1) * BUFB; LAS unsigned char* nxt = lds + ((it + 1) & 1) * BUFB;
        if (it + 1 < ntiles) ATT_DMA(jt - 1, nxt);
        bool wdone = false;
        if constexpr (TYPE == 1) wdone = __all(carry < 3.5527137e-15f);
        if (jt <= jd && !wdone) {
            const bool diag = (jt == jd);
            f32x16 S[2];
            const float negm = (TYPE == 0 && !diag) ? -m_run : 0.f;
#pragma unroll
            for (int kb = 0; kb < 2; ++kb) {
#pragma unroll
                for (int i = 0; i < 16; ++i) S[kb][i] = negm;
#pragma unroll
                for (int t = 0; t < NT; ++t) { const bf16x8 kf = *(const LAS bf16x8*)(cur + (32 * kb + pr) * KSTR + (16 * t + 8 * h) * 2);
                    S[kb] = __builtin_amdgcn_mfma_f32_32x32x16_bf16(kf, qf[t], S[kb], 0, 0, 0); }
            }
            if constexpr (TYPE == 0) {
                if (diag) {
#pragma unroll
                    for (int kb = 0; kb < 2; ++kb)
#pragma unroll
                        for (int i = 0; i < 16; ++i) { const int key = jt * 64 + 32 * kb + 16 * (i >> 3) + 8 * h + (i & 7); if (key > qrow) S[kb][i] = -INFINITY; }
                }
                float mx = S[0][0];
#pragma unroll
                for (int i = 1; i < 16; ++i) mx = fmaxf(mx, S[0][i]);
#pragma unroll
                for (int i = 0; i < 16; ++i) mx = fmaxf(mx, S[1][i]);
                mx = fmaxf(mx, __shfl_xor(mx, 32));
                const bool need = !diag && __any(mx > 8.f);
                const float dlt = diag ? mx : (mx > 8.f ? mx : 0.f);
                m_run = diag ? mx : m_run + dlt;
#pragma unroll
                for (int kb = 0; kb < 2; ++kb)
#pragma unroll
                    for (int i = 0; i < 16; ++i) S[kb][i] -= dlt;
                if (need) {
                    const float alpha = ex2(-dlt);
                    l_run *= alpha;
#pragma unroll
                    for (int d = 0; d < 4; ++d) O[d] = O[d] * alpha;
                }
#pragma unroll
                for (int kb = 0; kb < 2; ++kb)
#pragma unroll
                    for (int i = 0; i < 16; ++i) { const float p = ex2(S[kb][i]); l_run += p; S[kb][i] = p; }
            } else {
#pragma unroll
                for (int kb = 1; kb >= 0; --kb) {
                    float om[16]; float PA = 1.f, PB = 1.f;
#pragma unroll
                    for (int i = 0; i < 16; ++i) {
                        const float z = __builtin_amdgcn_fmed3f(S[kb][i], -60.f, 60.f);
                        const float ez = ex2(-z), bt = rcpf(1.f + ez);
                        const int key = jt * 64 + 32 * kb + 16 * (i >> 3) + 8 * h + (i & 7);
                        const bool valid = !diag || (key < qrow);
                        om[i] = valid ? ez * bt : 1.f;
                        S[kb][i] = valid ? bt : 0.f;
                        if (i < 8) PA *= om[i]; else PB *= om[i];
                    }
                    const float PAp = __shfl_xor(PA, 32), PBp = __shfl_xor(PB, 32);
                    float run = carry * (h == 0 ? PBp : 1.f);
#pragma unroll
                    for (int i = 15; i >= 8; --i) { const float a = S[kb][i] * run; run *= om[i]; S[kb][i] = a; }
                    run = carry * PB * PBp * (h == 0 ? PAp : 1.f);
#pragma unroll
                    for (int i = 7; i >= 0; --i) { const float a = S[kb][i] * run; run *= om[i]; S[kb][i] = a; }
                    carry *= (PA * PAp) * (PB * PBp);
                }
            }
            const LAS unsigned char* Vb = cur + KBUF;
#pragma unroll
            for (int kb = 0; kb < 2; ++kb)
#pragma unroll
                for (int s = 0; s < 2; ++s) {
                    u32x4 pw;
#pragma unroll
                    for (int k = 0; k < 4; ++k) pw[k] = pk2(S[kb][8 * s + 2 * k], S[kb][8 * s + 2 * k + 1]);
                    const bf16x8 pf = __builtin_bit_cast(bf16x8, pw);
#pragma unroll
                    for (int d = 0; d < 4; ++d) { const bf16x8 vf = *(const LAS bf16x8*)(Vb + (32 * d + r) * VSTR + (32 * kb + 16 * s + 8 * h) * 2);
                        O[d] = __builtin_amdgcn_mfma_f32_32x32x16_bf16(vf, pf, O[d], 0, 0, 0); }
                }
        }
        ATT_WAIT();
        if constexpr (TYPE == 1) {
            const int alld = __syncthreads_and((jt <= jd && __all(carry < 3.5527137e-15f)) ? 1 : 0);
            if (alld) break;
        } else __syncthreads();
    }
#undef ATT_DMA
#undef ATT_WAIT
    if constexpr (TYPE == 0) { const float lt = l_run + __shfl_xor(l_run, 32); const float inv = 1.f / lt;
#pragma unroll
        for (int d = 0; d < 4; ++d) O[d] = O[d] * inv; }
    float sq = 0.f;
#pragma unroll
    for (int d = 0; d < 4; ++d)
#pragma unroll
        for (int i = 0; i < 16; ++i) sq += O[d][i] * O[d][i];
    sq += __shfl_xor(sq, 32);
    float* ssp = P.ctl + (TYPE == 0 ? C_SSC : C_SSB) + l * M_TOK;
    if (h == 0 && accum) atomic_addf(ssp + grow, sq);
    const bf16_t* zp = P.proj + (size_t)grow * DINP + (TYPE == 0 ? OFF_ZC : OFF_ZB) + head * 128 + 4 * h;
    bf16_t* yp = P.yg + (size_t)grow * DM + (TYPE == 0 ? 2560 : 1024) + head * 128 + 4 * h;
    u32x2 zv[4][4];
#pragma unroll
    for (int d = 0; d < 4; ++d)
#pragma unroll
        for (int g4 = 0; g4 < 4; ++g4) zv[d][g4] = *(const u32x2*)(zp + 32 * d + 8 * g4);
#pragma unroll
    for (int d = 0; d < 4; ++d)
#pragma unroll
        for (int g4 = 0; g4 < 4; ++g4) {
            const u32x2 zz = zv[d][g4];
            u32x2 o; o.x = pk2(O[d][4 * g4] * silu(bflo(zz.x)), O[d][4 * g4 + 1] * silu(bfhi(zz.x)));
            o.y = pk2(O[d][4 * g4 + 2] * silu(bflo(zz.y)), O[d][4 * g4 + 3] * silu(bfhi(zz.y)));
            *(u32x2*)(yp + 32 * d + 8 * g4) = o;
        }
}

__global__ void __launch_bounds__(512, 2) mega(Args a) {
    extern __shared__ __attribute__((aligned(16))) unsigned char lds_raw[];
    LAS unsigned char* lds = (LAS unsigned char*)lds_raw;
    cg::grid_group grid = cg::this_grid();
    Ptrs P;
    P.x = a.in[0]; P.pos = (const int*)a.in[1]; P.g_pre = a.in[2]; P.w_in = a.in[3]; P.a_g_v = a.in[4]; P.a_w_s = a.in[5]; P.a_b_s = a.in[6];
    P.c_g_q = a.in[7]; P.c_g_kv = a.in[8]; P.c_w_uq = a.in[9]; P.c_w_ukv = a.in[10]; P.g_out = a.in[11]; P.w_out = a.in[12]; P.g_final = a.in[13];
    P.out = a.out; unsigned char* ws = a.ws;
    P.ctl = (float*)(ws + WS_CTL); P.cnt = (unsigned*)(ws + WS_CTL) + C_CNT;
    P.win = (bf16_t*)(ws + WS_WIN); P.wout = (bf16_t*)(ws + WS_WOUT); P.wuq = (bf16_t*)(ws + WS_WUQ); P.wukv = (bf16_t*)(ws + WS_WUKV);
    P.xb = (bf16_t*)(ws + WS_XB); P.proj = (bf16_t*)(ws + WS_PROJ); P.vbt = (bf16_t*)(ws + WS_VBT); P.qc = (bf16_t*)(ws + WS_QC);
    P.kc = (bf16_t*)(ws + WS_KC); P.vct = (bf16_t*)(ws + WS_VCT); P.yg = (bf16_t*)(ws + WS_YG);
    P.cosT = (float*)(ws + WS_COS); P.sinT = (float*)(ws + WS_SIN);
    const int G = gridDim.x, bid = blockIdx.x;
    const int wave_id = __builtin_amdgcn_readfirstlane((int)threadIdx.x >> 6);

    for (int ph = a.ph_lo; ph < a.ph_hi; ++ph) {
        int tid; asm volatile("v_mbcnt_lo_u32_b32 %0, -1, 0\n\tv_mbcnt_hi_u32_b32 %0, -1, %0" : "=v"(tid)); tid += wave_id * 64;
        if (ph == 0) {
            phase0(tid, lds, P);
            __syncthreads();
        } else if (ph == 9) {
            const int lane = tid & 63, gw = bid * 8 + (tid >> 6), NGW = G * 8;
            const float* ss = P.ctl + C_SSX + 2 * M_TOK;
            for (int row = gw; row < M_TOK; row += NGW) {
                const float rs = rsqrtf(ss[row] * (1.f / 4096.f) + EPS);
                f32x4* o = (f32x4*)(P.out + (size_t)row * DM) + lane; const f32x4* gf = (const f32x4*)P.g_final + lane;
                const u32x2* xi = (const u32x2*)(P.xb + (size_t)row * DM) + lane;
                u32x2 xv[16]; f32x4 gv[16];
#pragma unroll
                for (int j = 0; j < 16; ++j) { xv[j] = xi[64 * j]; gv[j] = gf[64 * j]; }
#pragma unroll
                for (int j = 0; j < 16; ++j) { const u32x2 w = xv[j]; const f32x4 v = {bflo(w.x), bfhi(w.x), bflo(w.y), bfhi(w.y)}; o[64 * j] = v * rs * gv[j]; }
            }
        } else {
            const int l = (ph - 1) >> 2, k = (ph - 1) & 3;
            if (k == 0) {
                pg8::Gemm g{P.xb, P.win + (size_t)l * DINP * DM, DM, DM, DM, M_TOK, DINP};
                pg8::StaticOrder S; S.init(M_TOK, DINP, G, bid);
                EpiInProj E{P.proj, P.vbt, P.ctl + C_SSX + l * M_TOK, P.ctl + C_SSQ + l * M_TOK, P.ctl + C_SSKV + l * M_TOK, true, lds + XPOSE_OFF + (tid >> 6) * 1024};
                pg8::gemm_phase<EpiInProj>(tid, lds, g, S, E);
            } else if (k == 1) {
                {
                {
                    pg8::Gemm g{P.proj + OFF_CKV, P.wukv + (size_t)l * NUKV * KVL, DINP, KVL, KVL, M_TOK, NUKV};
                    pg8::StaticOrder S; S.init(M_TOK, NUKV, G, (bid + G / 2) % G);
                    EpiUKV E{P.kc, P.vct, P.ctl + C_SSKV + l * M_TOK, lds + XPOSE_OFF + (tid >> 6) * 1024};
                    pg8::gemm_phase<EpiUKV>(tid, lds, g, S, E);
                }
                {
                    pg8::Gemm g{P.proj + OFF_CQ, P.wuq + (size_t)l * NUQ * QL, DINP, QL, QL, M_TOK, NUQ};
                    pg8::StaticOrder S; S.init(M_TOK, NUQ, G, bid);
                    EpiUQ E{P.qc, P.ctl + C_SSQ + l * M_TOK};
                    pg8::gemm_phase<EpiUQ>(tid, lds, g, S, E);
                }
                rope_kr(tid, P);
                for (int it = bid; it < 512; it += G) gmlp_item(tid, lds, it, P, l, true);
                }
            } else if (k == 2) {
                volatile LAS unsigned* qw = (volatile LAS unsigned*)(lds + RING_BYTES);
                { const int rep = 0;
                for (;;) {
                    if (tid == 0) *qw = atomicAdd(P.cnt + l + 2 * rep, 1u);
                    __syncthreads();
                    const unsigned idx = *qw;
                    __syncthreads();
                    if (idx >= 768u) break;
                    const int qb = 15 - (int)(idx / 48u), rem = (int)(idx % 48u), type = rem / 24, bh = rem % 24;
                    int t2 = tid; asm volatile("" : "+v"(t2));
                    if (type == 0) attn_item<0>(t2, lds, bh, qb, P, l, rep == 0); else attn_item<1>(t2, lds, bh, qb, P, l, rep == 0);
                }
                }
            } else {
                pg8::Gemm g{P.yg, P.wout + (size_t)l * DM * DM, DM, DM, DM, M_TOK, DM};
                pg8::StaticOrder S; S.init(M_TOK, DM, G, bid);
                EpiOut E{P.xb, (float*)nullptr, P.xb, P.ctl + C_SSX + (l + 1) * M_TOK,
                         P.ctl + C_SSA + l * M_TOK, P.ctl + C_SSB + l * M_TOK, P.ctl + C_SSC + l * M_TOK, true, (LAS float*)(lds + XPOSE_OFF)};
                pg8::gemm_phase<EpiOut>(tid, lds, g, S, E);
            }
        }
        if (ph + 1 < a.ph_hi) grid.sync();
    }
}

extern "C" void kernel_launch(void* const* d_in, const int* in_sizes, int n_in, void* d_out, int out_size, void* d_ws, size_t ws_size, hipStream_t stream) {
    static int grid = 0;
    if (grid == 0) {
        if (n_in != 14 || ws_size < WS_END || out_size != M_TOK * DM) { fprintf(stderr, "kernel_launch: unexpected shapes (n_in %d, ws %zu, out %d)\n", n_in, ws_size, out_size); grid = -1; return; }
        int dev = 0, cus = 0, per_cu = 0;
        hipGetDevice(&dev);
        hipDeviceGetAttribute(&cus, hipDeviceAttributeMultiprocessorCount, dev);
        if (hipFuncSetAttribute((const void*)mega, hipFuncAttributeMaxDynamicSharedMemorySize, LDS_BYTES) != hipSuccess) { fprintf(stderr, "kernel_launch: hipFuncSetAttribute failed\n"); grid = -1; return; }
        if (hipOccupancyMaxActiveBlocksPerMultiprocessor(&per_cu, (const void*)mega, 512, LDS_BYTES) != hipSuccess || per_cu < 1) { fprintf(stderr, "kernel_launch: occupancy query gives %d\n", per_cu); per_cu = 1; }
        (void)hipGetLastError();
        grid = cus * 1;
    }
    if (grid < 0) return;
    hipMemsetAsync((char*)d_ws + WS_CTL, 0, CTL_BYTES, stream);
    Args a{};
    for (int i = 0; i < 14; ++i) a.in[i] = (const float*)d_in[i];
    a.out = (float*)d_out; a.ws = (unsigned char*)d_ws;
#if N_LAUNCH == 1
    a.ph_lo = 0; a.ph_hi = 10;
    void* args[] = {&a};
    hipError_t e = hipLaunchCooperativeKernel((const void*)mega, dim3(grid), dim3(512), args, LDS_BYTES, stream);
    if (e != hipSuccess) fprintf(stderr, "cooperative launch failed: %s (grid %d)\n", hipGetErrorString(e), grid);
#else
    for (int ph = 0; ph < 10; ++ph) {
        a.ph_lo = ph; a.ph_hi = ph + 1;
        hipLaunchKernelGGL(mega, dim3(grid), dim3(512), LDS_BYTES, stream, a);
    }
#endif
}
```

```cpp
#include <hip/hip_runtime.h>
#include <hip/hip_cooperative_groups.h>
#include <cstdio>
#include <cstdint>
namespace cg = cooperative_groups;

#ifndef N_LAUNCH
#define N_LAUNCH 1
#endif

#define DI __device__ __forceinline__
#define LAS __attribute__((address_space(3)))
typedef unsigned short bf16_t;
typedef short bf16x8 __attribute__((ext_vector_type(8)));
typedef float f32x4 __attribute__((ext_vector_type(4)));
typedef float f32x16 __attribute__((ext_vector_type(16)));
typedef unsigned u32x4 __attribute__((ext_vector_type(4)));
typedef unsigned u32x2 __attribute__((ext_vector_type(2)));
typedef float f32x2_t __attribute__((ext_vector_type(2)));
typedef __bf16 bf16x2_t __attribute__((ext_vector_type(2)));

constexpr int M_TOK = 8192, SEQ = 4096, DM = 4096, DIN = 12096, DINP = 12288, NHEAD = 12;
constexpr int OFF_UA = 0, OFF_VA = 1024, OFF_ZA = 2048, OFF_QB = 3072, OFF_KB = 4608, OFF_VB = 6144, OFF_ZB = 7680,
              OFF_CQ = 9216, OFF_CKV = 9984, OFF_KR = 10496, OFF_ZC = 10560;
constexpr int QL = 768, KVL = 512, NUQ = 2304, NUKV = 3072;
constexpr float EPS = 1e-6f, LOG2E = 1.4426950408889634f;
constexpr float QSB = 0.08838834764831845f * LOG2E;
constexpr float QSC = 0.07216878364870323f * LOG2E;

constexpr size_t MiB = 1u << 20;
constexpr size_t WS_CTL = 0, CTL_BYTES = 1 * MiB;
constexpr size_t WS_WIN = 1 * MiB, WS_WOUT = 193 * MiB, WS_WUQ = 257 * MiB, WS_WUKV = 264 * MiB, WS_XB = 270 * MiB, WS_PROJ = 334 * MiB,
                 WS_VBT = 526 * MiB, WS_QC = 550 * MiB, WS_KNC = 586 * MiB, WS_VCT = 610 * MiB, WS_KR = 634 * MiB, WS_COS = 635 * MiB,
                 WS_SIN = 636 * MiB, WS_YG = 637 * MiB, WS_KC = 701 * MiB, WS_END = 829 * MiB;
constexpr int C_SSX = 0;
constexpr int C_SSQ = 3 * 8192;
constexpr int C_SSKV = 5 * 8192;
constexpr int C_SSA = 7 * 8192, C_SSB = 9 * 8192, C_SSC = 11 * 8192;
constexpr int C_CNT = 13 * 8192;

constexpr int RING_BYTES = 131072, XPOSE_OFF = RING_BYTES + 256, LDS_BYTES = XPOSE_OFF + 8192;

DI unsigned pk2(float lo, float hi) { f32x2_t v = {lo, hi}; bf16x2_t b = __builtin_convertvector(v, bf16x2_t); return __builtin_bit_cast(unsigned, b); }
DI bf16_t f2bf(float f) { return (bf16_t)(pk2(f, 0.f) & 0xffffu); }
DI float bflo(unsigned w) { return __builtin_bit_cast(float, w << 16); }
DI float bfhi(unsigned w) { return __builtin_bit_cast(float, w & 0xffff0000u); }
DI float bf2f(bf16_t u) { return __builtin_bit_cast(float, (unsigned)u << 16); }
DI float ex2(float x) { return __builtin_amdgcn_exp2f(x); }
DI float lg2(float x) { return __builtin_amdgcn_logf(x); }
DI float rcpf(float x) { return __builtin_amdgcn_rcpf(x); }
DI float silu(float z) { return z * rcpf(1.f + ex2(-z * LOG2E)); }
DI float gelu_tanh(float x) { const float u = 0.7978845608028654f * (x + 0.044715f * x * x * x); return x * rcpf(1.f + ex2(-2.f * LOG2E * u)); }
DI float wave_sum(float v) {
#pragma unroll
    for (int o = 1; o < 64; o <<= 1) v += __shfl_xor(v, o);
    return v;
}
DI void atomic_addf(float* p, float v) { __hip_atomic_fetch_add(p, v, __ATOMIC_RELAXED, __HIP_MEMORY_SCOPE_AGENT); }
#define LDS_WAIT() asm volatile("s_waitcnt lgkmcnt(0)" ::: "memory")

namespace pg8 {
constexpr int BM = 256, BK = 64, HALF = 128, HTB = HALF * BK * 2, STAGE_BYTES = 8 * HTB, NXCD = 8, WGM = 8;
DI int lds_byte(int r, int c) { const int st = (r >> 4) * 2 + (c >> 5), rr = r & 15, cc = c & 31, ob = rr * 64 + cc * 2; return st * 1024 + (ob ^ (((ob >> 9) & 1) << 5)); }
DI void stage_rc(int b, int& R, int& C) { const int st = b / 1024, sb = b % 1024, swz = sb ^ (((sb >> 9) & 1) << 5); R = (st >> 1) * 16 + swz / 64; C = (st & 1) * 32 + (swz % 64) / 2; }
DI int perm32(int rho) { const int n = rho >> 4, i = rho & 15; return 8 * (i >> 2) + 4 * n + (i & 3); }

struct Unit { int pm, pn; };
struct Gemm { const bf16_t* A; const bf16_t* Bt; int lda, ldb, K, M, N; };

struct StaticOrder {
    int nM, nN, nwg, G, c;
    DI void init(int M, int N, int G_, int c_) { nM = M / BM; nN = N / BM; nwg = nM * nN; G = G_; c = c_; }
    DI bool next(int i, Unit& u) const {
        const long L = (long)i * G + c; if (L >= nwg) return false;
        int wgid = (int)L; { const int q = nwg / NXCD, r = nwg % NXCD, xcd = wgid % NXCD, off = wgid / NXCD; wgid = (xcd < r ? xcd * (q + 1) : r * (q + 1) + (xcd - r) * q) + off; }
        const int nig = WGM * nN, gid = wgid / nig, fm = gid * WGM, gsz = (nM - fm) < WGM ? (nM - fm) : WGM;
        u.pm = fm + ((wgid % nig) % gsz); u.pn = (wgid % nig) / gsz; return true;
    }
};

template <class Epi, bool ALIGN_EPI = true>
DI void gemm_phase(const int tid, LAS unsigned char* lds, const Gemm g, const StaticOrder& S, const Epi& E) {
    const int wid = __builtin_amdgcn_readfirstlane(tid >> 6), lane = tid & 63, wr = wid >> 2, wc = wid & 3, fr = lane & 15, fq = lane >> 4;
    const int K = g.K, nt = K / BK;
    unsigned voffA[2], voffB[2];
#pragma unroll
    for (int i = 0; i < 2; ++i) { int R, C; stage_rc(tid * 16 + i * 8192, R, C); const int Rb = (R & ~31) + perm32(R & 31);
        voffA[i] = (unsigned)(R * g.lda + C) * 2u; voffB[i] = (unsigned)(Rb * g.ldb + C) * 2u; }
    const size_t kstep = (size_t)(BK * 2);
    const size_t hstepA = (size_t)HALF * g.lda * 2, hstepB = (size_t)HALF * g.ldb * 2;
    const size_t tstepA = 2 * hstepA, tstepB = 2 * hstepB;
    const unsigned ldsw = (unsigned)wid * 1024u;
    const int aoff = lds_byte(wr * 64 + fr, fq * 8), boff = lds_byte(wc * 32 + fr, fq * 8);
#define PG8_SA(b, h) (((b) * 2 + (h)) * HTB)
#define PG8_SB(b, h) ((4 + (b) * 2 + (h)) * HTB)
#define PG8_STAGE(bufoff, gbase, voff) do { _Pragma("unroll") for (int _i = 0; _i < 2; ++_i) \
        __builtin_amdgcn_global_load_lds((const unsigned*)((const char*)(gbase) + (voff)[_i]), (LAS unsigned*)(lds + (bufoff) + ldsw + _i * 8192), 16, 0, 0); } while (0)
#define PG8_LDA(dst, b, h) do { _Pragma("unroll") for (int m = 0; m < 4; ++m) _Pragma("unroll") for (int k = 0; k < 2; ++k) dst[m][k] = *(const LAS bf16x8*)(lds + PG8_SA(b, h) + aoff + m * 2048 + k * 1024); } while (0)
#define PG8_LDB(dst, b, h) do { _Pragma("unroll") for (int n = 0; n < 2; ++n) _Pragma("unroll") for (int k = 0; k < 2; ++k) dst[n][k] = *(const LAS bf16x8*)(lds + PG8_SB(b, h) + boff + n * 2048 + k * 1024); } while (0)
#define PG8_MMA(ai, bj, At, Bt) do { __builtin_amdgcn_s_setprio(1); _Pragma("unroll") for (int m = 0; m < 4; ++m) _Pragma("unroll") for (int n = 0; n < 2; ++n) _Pragma("unroll") for (int k = 0; k < 2; ++k) \
        acc[ai][bj][m][n] = __builtin_amdgcn_mfma_f32_16x16x32_bf16(Bt[n][k], At[m][k], acc[ai][bj][m][n], 0, 0, 0); __builtin_amdgcn_s_setprio(0); } while (0)
#define PG8_WAIT_V(n) asm volatile("s_waitcnt vmcnt(" #n ")" ::: "memory")
#define PG8_WAIT_L(n) asm volatile("s_waitcnt lgkmcnt(" #n ")" ::: "memory")
#define PG8_BAR __builtin_amdgcn_s_barrier()
#define PG8_SCHED __builtin_amdgcn_sched_barrier(0)
    Unit cur, nxt; int ui = 0;
    if (!S.next(0, cur)) return;
    f32x4 acc[2][2][4][2];
#pragma unroll
    for (int a = 0; a < 2; ++a)
#pragma unroll
        for (int b = 0; b < 2; ++b)
#pragma unroll
            for (int m = 0; m < 4; ++m)
#pragma unroll
                for (int n = 0; n < 2; ++n) acc[a][b][m][n] = (f32x4){0.f, 0.f, 0.f, 0.f};
    bf16x8 At[4][2], B0[2][2], B1[2][2];
    const char* cA = (const char*)g.A + (size_t)cur.pm * tstepA; const char* cB = (const char*)g.Bt + (size_t)cur.pn * tstepB;
    PG8_STAGE(PG8_SB(0, 0), cB, voffB); PG8_STAGE(PG8_SB(0, 1), cB + hstepB, voffB); PG8_STAGE(PG8_SA(0, 0), cA, voffA); PG8_STAGE(PG8_SA(0, 1), cA + hstepA, voffA);
    if (wr == 1) PG8_BAR;
    PG8_WAIT_V(2); PG8_BAR;
    PG8_STAGE(PG8_SB(1, 0), cB + kstep, voffB); PG8_STAGE(PG8_SA(1, 0), cA + kstep, voffA); PG8_STAGE(PG8_SB(1, 1), cB + hstepB + kstep, voffB);
    PG8_WAIT_V(6); PG8_BAR;
    if constexpr (Epi::KSCALE) E.preload(cur, tid);
    for (;;) {
        const bool has_next = S.next(ui + 1, nxt);
        const char* nA = has_next ? (const char*)g.A + (size_t)nxt.pm * tstepA : cA; const char* nB = has_next ? (const char*)g.Bt + (size_t)nxt.pn * tstepB : cB;
        for (int t = 0; t < nt; t += 2) {
            const bool last = (t == nt - 2);
            const char* a1 = cA + (size_t)(t + 1) * kstep;
            const char* a2 = last ? nA : cA + (size_t)(t + 2) * kstep; const char* b2 = last ? nB : cB + (size_t)(t + 2) * kstep;
            const char* a3 = a2 + kstep; const char* b3 = b2 + kstep;
            if constexpr (Epi::KSCALE) { if (t == Epi::KS1 || t == Epi::KS2) E.kscale(acc, cur, t, wr, fr); }
            PG8_LDB(B0, 0, 0); PG8_LDB(B1, 0, 1); PG8_SCHED; PG8_LDA(At, 0, 0); PG8_STAGE(PG8_SA(1, 1), a1 + hstepA, voffA);
            PG8_WAIT_V(8); PG8_WAIT_L(0); PG8_BAR; PG8_MMA(0, 0, At, B0); PG8_MMA(0, 1, At, B1); PG8_BAR; PG8_SCHED;
            PG8_LDA(At, 0, 1); PG8_STAGE(PG8_SB(0, 0), b2, voffB); PG8_STAGE(PG8_SB(0, 1), b2 + hstepB, voffB); PG8_STAGE(PG8_SA(0, 0), a2, voffA);
            PG8_WAIT_V(8); PG8_WAIT_L(0); PG8_BAR; PG8_MMA(1, 0, At, B0); PG8_MMA(1, 1, At, B1); PG8_BAR; PG8_SCHED;
            PG8_LDB(B0, 1, 0); PG8_LDB(B1, 1, 1); PG8_SCHED; PG8_LDA(At, 1, 0); PG8_STAGE(PG8_SA(0, 1), a2 + hstepA, voffA);
            PG8_WAIT_V(8); PG8_WAIT_L(0); PG8_BAR; PG8_MMA(0, 0, At, B0); PG8_MMA(0, 1, At, B1); PG8_BAR; PG8_SCHED;
            PG8_LDA(At, 1, 1); PG8_STAGE(PG8_SB(1, 0), b3, voffB); PG8_STAGE(PG8_SB(1, 1), b3 + hstepB, voffB); PG8_STAGE(PG8_SA(1, 0), a3, voffA);
            PG8_WAIT_V(8); PG8_WAIT_L(0); PG8_BAR; PG8_MMA(1, 0, At, B0); PG8_MMA(1, 1, At, B1); PG8_BAR; PG8_SCHED;
        }
        if constexpr (ALIGN_EPI) { if (wr == 0) PG8_BAR; }
        E(acc, cur, wr, wc, fr, fq);
        if (!has_next) break;
#pragma unroll
        for (int a = 0; a < 2; ++a)
#pragma unroll
            for (int b = 0; b < 2; ++b)
#pragma unroll
                for (int m = 0; m < 4; ++m)
#pragma unroll
                    for (int n = 0; n < 2; ++n) acc[a][b][m][n] = (f32x4){0.f, 0.f, 0.f, 0.f};
        cur = nxt; cA = nA; cB = nB; ++ui;
        if constexpr (Epi::KSCALE) E.preload(cur, tid);
        if constexpr (ALIGN_EPI) { if (wr == 1) PG8_BAR; }
    }
    PG8_WAIT_V(0);
    if constexpr (!ALIGN_EPI) { if (wr == 0) PG8_BAR; }
    PG8_BAR;
#undef PG8_SA
#undef PG8_SB
#undef PG8_STAGE
#undef PG8_LDA
#undef PG8_LDB
#undef PG8_MMA
#undef PG8_WAIT_V
#undef PG8_WAIT_L
#undef PG8_BAR
#undef PG8_SCHED
}
}

typedef f32x4 acc_t[2][2][4][2];

DI void store8_bf16(bf16_t* p, f32x4 v0, f32x4 v1) {
    u32x4 w; w.x = pk2(v0[0], v0[1]); w.y = pk2(v0[2], v0[3]); w.z = pk2(v1[0], v1[1]); w.w = pk2(v1[2], v1[3]);
    *(u32x4*)p = w;
}
DI size_t vt_index(int bh, int s, int d) { return ((size_t)(bh * 256 + (s >> 4)) * 128 + d) * 16 + (s & 15); }
DI void store_T_wave(LAS unsigned char* scr, bf16_t* vt0, int fr, int fq, int lane, f32x4 v0, f32x4 v1) {
    LAS bf16_t* w = (LAS bf16_t*)(scr + (8 * fq) * 32 + fr * 2);
    w[0 * 16] = f2bf(v0[0]); w[1 * 16] = f2bf(v0[1]); w[2 * 16] = f2bf(v0[2]); w[3 * 16] = f2bf(v0[3]);
    w[4 * 16] = f2bf(v1[0]); w[5 * 16] = f2bf(v1[1]); w[6 * 16] = f2bf(v1[2]); w[7 * 16] = f2bf(v1[3]);
    const u32x4 c = *(const LAS u32x4*)(scr + lane * 16);
    *(u32x4*)(vt0 + lane * 8) = c;
}
DI float sumsq8(f32x4 a, f32x4 b) { return (a[0] * a[0] + a[1] * a[1]) + (a[2] * a[2] + a[3] * a[3]) + (b[0] * b[0] + b[1] * b[1]) + (b[2] * b[2] + b[3] * b[3]); }

struct EpiInProj {
    static constexpr bool KSCALE = false; static constexpr int KS1 = -1, KS2 = -1;
    bf16_t* proj; bf16_t* vbt; const float* ssx; float* ssq; float* sskv; bool accum; LAS unsigned char* scr;
    DI void kscale(acc_t&, const pg8::Unit&, int, int, int) const {}
    DI void operator()(const acc_t& acc, const pg8::Unit& u, int wr, int wc, int fr, int fq) const {
        const int pn = u.pn;
        const int row0 = u.pm * 256 + wr * 64 + fr, colb = pn * 256 + wc * 32 + 8 * fq;
        const bool isq = (pn >= 12 && pn < 18), isv = (pn >= 24 && pn < 30), isn = (pn >= 36 && pn < 41);
        float ssv[2][4];
#pragma unroll
        for (int ai = 0; ai < 2; ++ai)
#pragma unroll
            for (int m = 0; m < 4; ++m) ssv[ai][m] = ssx[row0 + ai * 128 + m * 16];
#pragma unroll
        for (int ai = 0; ai < 2; ++ai)
#pragma unroll
            for (int m = 0; m < 4; ++m) {
                const int row = row0 + ai * 128 + m * 16;
                float rs = rsqrtf(ssv[ai][m] * (1.f / 4096.f) + EPS);
                if (isq) rs *= QSB;
                float sq = 0.f;
#pragma unroll
                for (int bj = 0; bj < 2; ++bj) {
                    const int col = colb + bj * 128;
                    const f32x4 v0 = acc[ai][bj][m][0] * rs, v1 = acc[ai][bj][m][1] * rs;
                    if (isv) {
                        const int head = 2 * (pn - 24) + bj, b = row >> 12, s0 = (row & 4095) & ~15;
                        store_T_wave(scr, vbt + vt_index(b * NHEAD + head, s0, wc * 32), fr, fq, fq * 16 + fr, v0, v1);
                    } else if (col < DIN) {
                        store8_bf16(proj + (size_t)row * DINP + col, v0, v1);
                    }
                    sq += sumsq8(v0, v1);
                }
                if (isn && accum) {
                    sq += __shfl_xor(sq, 16); sq += __shfl_xor(sq, 32);
                    if (fq == 0) atomic_addf((pn < 39 ? ssq : sskv) + row, sq);
                }
            }
    }
};

struct EpiUQ {
    static constexpr bool KSCALE = false; static constexpr int KS1 = -1, KS2 = -1;
    bf16_t* qc; const float* ssq;
    DI void kscale(acc_t&, const pg8::Unit&, int, int, int) const {}
    DI void operator()(const acc_t& acc, const pg8::Unit& u, int wr, int wc, int fr, int fq) const {
        const int row0 = u.pm * 256 + wr * 64 + fr, colb = u.pn * 256 + wc * 32 + 8 * fq;
        float ssv[2][4];
#pragma unroll
        for (int ai = 0; ai < 2; ++ai)
#pragma unroll
            for (int m = 0; m < 4; ++m) ssv[ai][m] = ssq[row0 + ai * 128 + m * 16];
#pragma unroll
        for (int ai = 0; ai < 2; ++ai)
#pragma unroll
            for (int m = 0; m < 4; ++m) {
                const int row = row0 + ai * 128 + m * 16;
                const float rs = rsqrtf(ssv[ai][m] * (1.f / 768.f) + EPS) * QSC;
#pragma unroll
                for (int bj = 0; bj < 2; ++bj)
                    store8_bf16(qc + (size_t)row * NUQ + colb + bj * 128, acc[ai][bj][m][0] * rs, acc[ai][bj][m][1] * rs);
            }
    }
};

struct EpiUKV {
    static constexpr bool KSCALE = false; static constexpr int KS1 = -1, KS2 = -1;
    bf16_t* kc; bf16_t* vct; const float* sskv; LAS unsigned char* scr;
    DI void kscale(acc_t&, const pg8::Unit&, int, int, int) const {}
    DI void operator()(const acc_t& acc, const pg8::Unit& u, int wr, int wc, int fr, int fq) const {
        const int row0 = u.pm * 256 + wr * 64 + fr, head = u.pn, d0 = wc * 32 + 8 * fq;
        float ssv[2][4];
#pragma unroll
        for (int ai = 0; ai < 2; ++ai)
#pragma unroll
            for (int m = 0; m < 4; ++m) ssv[ai][m] = sskv[row0 + ai * 128 + m * 16];
#pragma unroll
        for (int ai = 0; ai < 2; ++ai)
#pragma unroll
            for (int m = 0; m < 4; ++m) {
                const int row = row0 + ai * 128 + m * 16;
                const float rs = rsqrtf(ssv[ai][m] * (1.f / 512.f) + EPS);
                store8_bf16(kc + (size_t)row * NUQ + head * 192 + d0, acc[ai][0][m][0] * rs, acc[ai][0][m][1] * rs);
                const int b = row >> 12, s0 = (row & 4095) & ~15;
                store_T_wave(scr, vct + vt_index(b * NHEAD + head, s0, wc * 32), fr, fq, fq * 16 + fr, acc[ai][1][m][0] * rs, acc[ai][1][m][1] * rs);
            }
    }
};

struct EpiOut {
    static constexpr bool KSCALE = true; static constexpr int KS1 = 16, KS2 = 40;
    const bf16_t* xin; float* xout; bf16_t* xb; float* ssn; const float *ssa, *ssb, *ssc; bool accum;
    LAS float* fac;
    DI void preload(const pg8::Unit& u, int tid) const {
        const int rl = tid & 255, which = tid >> 8, row = u.pm * 256 + rl;
        const float va = ssa[row], vb = ssb[row], vc = ssc[row];
        const float rb = rsqrtf(vb * (1.f / 1536.f) + EPS);
        fac[which * 256 + rl] = which == 0 ? rsqrtf(va * (1.f / 1024.f) + EPS) / rb : rb / rsqrtf(vc * (1.f / 1536.f) + EPS);
    }
    DI void kscale(acc_t& acc, const pg8::Unit& u, int t, int wr, int fr) const {
        const LAS float* fp = fac + (t == KS1 ? 0 : 256) + wr * 64 + fr;
#pragma unroll
        for (int ai = 0; ai < 2; ++ai)
#pragma unroll
            for (int m = 0; m < 4; ++m) {
                const float f = fp[ai * 128 + m * 16];
#pragma unroll
                for (int bj = 0; bj < 2; ++bj)
#pragma unroll
                    for (int n = 0; n < 2; ++n) acc[ai][bj][m][n] *= f;
            }
    }
    DI void operator()(const acc_t& acc, const pg8::Unit& u, int wr, int wc, int fr, int fq) const {
        const int row0 = u.pm * 256 + wr * 64 + fr, colb = u.pn * 256 + wc * 32 + 8 * fq;
#pragma unroll
        for (int ai = 0; ai < 2; ++ai) {
            u32x4 xw[4][2]; float sv[4];
#pragma unroll
            for (int m = 0; m < 4; ++m) { const int row = row0 + ai * 128 + m * 16; sv[m] = ssc[row];
#pragma unroll
                for (int bj = 0; bj < 2; ++bj) xw[m][bj] = *(const u32x4*)(xin + (size_t)row * DM + colb + bj * 128); }
#pragma unroll
            for (int m = 0; m < 4; ++m) {
                const int row = row0 + ai * 128 + m * 16;
                const float rc = rsqrtf(sv[m] * (1.f / 1536.f) + EPS);
                float sq = 0.f;
#pragma unroll
                for (int bj = 0; bj < 2; ++bj) {
                    const size_t o = (size_t)row * DM + colb + bj * 128;
                    const u32x4 w = xw[m][bj];
                    const f32x4 x0 = {bflo(w.x), bfhi(w.x), bflo(w.y), bfhi(w.y)}, x1 = {bflo(w.z), bfhi(w.z), bflo(w.w), bfhi(w.w)};
                    const f32x4 o0 = x0 + acc[ai][bj][m][0] * rc, o1 = x1 + acc[ai][bj][m][1] * rc;
                    if (xout) { *(f32x4*)(xout + o) = o0; *(f32x4*)(xout + o + 4) = o1; }
                    if (xb) store8_bf16(xb + o, o0, o1);
                    sq += sumsq8(o0, o1);
                }
                sq += __shfl_xor(sq, 16); sq += __shfl_xor(sq, 32);
                if (fq == 0 && accum) atomic_addf(ssn + row, sq);
            }
        }
    }
};

struct Args { const float* in[14]; float* out; unsigned char* ws; int ph_lo, ph_hi; };
struct Ptrs {
    const float *x, *g_pre, *w_in, *a_g_v, *a_w_s, *a_b_s, *c_g_q, *c_g_kv, *c_w_uq, *c_w_ukv, *g_out, *w_out, *g_final; const int* pos;
    float* out; float* ctl; unsigned* cnt;
    bf16_t *win, *wout, *wuq, *wukv, *xb, *proj, *vbt, *qc, *kc, *vct, *yg; float *cosT, *sinT;
};

DI void p0_transpose_item(const float* W, const float* gk, int K, int N, bf16_t* WT, LAS float* scr, int item, int lane) {
    const int nblk = N / 32, kb = item / nblk, nb = item % nblk, k0 = 64 * kb, n0 = 32 * nb;
#pragma unroll 8
    for (int i = 0; i < 32; ++i) { const int kk = 2 * i + (lane >> 5); scr[kk * 33 + (lane & 31)] = __builtin_nontemporal_load(&W[(size_t)(k0 + kk) * N + n0 + (lane & 31)]) * gk[k0 + kk]; }
    LDS_WAIT();
    const int c = lane & 7;
#pragma unroll
    for (int j = 0; j < 4; ++j) { const int n = (lane >> 3) + 8 * j; const LAS float* s = scr + (8 * c) * 33 + n;
        u32x4 o; o.x = pk2(s[0 * 33], s[1 * 33]); o.y = pk2(s[2 * 33], s[3 * 33]); o.z = pk2(s[4 * 33], s[5 * 33]); o.w = pk2(s[6 * 33], s[7 * 33]);
        *(u32x4*)(WT + (size_t)(n0 + n) * K + k0 + 8 * c) = o; }
    LDS_WAIT();
}

DI void phase0(const int tid, LAS unsigned char* lds, const Ptrs& P) {
    const int lane = tid & 63, wave = tid >> 6, G = gridDim.x;
    const int gw = blockIdx.x * 8 + wave, NGW = G * 8;
    LAS float* scr = (LAS float*)(lds + wave * 8448);
    constexpr int I_IN = (DM / 64) * (DIN / 32), I_OUT = (DM / 64) * (DM / 32), I_UQ = (QL / 64) * (NUQ / 32), I_UKV = (KVL / 64) * (NUKV / 32);
    constexpr int I_L = I_IN + I_OUT + I_UQ + I_UKV;
    for (int it = gw; it < 2 * I_L; it += NGW) {
        const int l = it / I_L; int r = it % I_L;
        if (r < I_IN) { p0_transpose_item(P.w_in + (size_t)l * DM * DIN, P.g_pre + l * DM, DM, DIN, P.win + (size_t)l * DINP * DM, scr, r, lane); continue; } r -= I_IN;
        if (r < I_OUT) { p0_transpose_item(P.w_out + (size_t)l * DM * DM, P.g_out + l * DM, DM, DM, P.wout + (size_t)l * DM * DM, scr, r, lane); continue; } r -= I_OUT;
        if (r < I_UQ) { p0_transpose_item(P.c_w_uq + (size_t)l * QL * NUQ, P.c_g_q + l * QL, QL, NUQ, P.wuq + (size_t)l * NUQ * QL, scr, r, lane); continue; } r -= I_UQ;
        p0_transpose_item(P.c_w_ukv + (size_t)l * KVL * NUKV, P.c_g_kv + l * KVL, KVL, NUKV, P.wukv + (size_t)l * NUKV * KVL, scr, r, lane);
    }
    for (int row = gw; row < M_TOK; row += NGW) {
        const f32x4* xr = (const f32x4*)(P.x + (size_t)row * DM) + lane;
        u32x2* o8 = (u32x2*)(P.xb + (size_t)row * DM) + lane;
        float s = 0.f;
        f32x4 xv[16];
#pragma unroll
        for (int j = 0; j < 16; ++j) xv[j] = __builtin_nontemporal_load(&xr[64 * j]);
#pragma unroll
        for (int j = 0; j < 16; ++j) { const f32x4 v = xv[j]; s += (v[0] * v[0] + v[1] * v[1]) + (v[2] * v[2] + v[3] * v[3]);
            u32x2 w; w.x = pk2(v[0], v[1]); w.y = pk2(v[2], v[3]); o8[64 * j] = w; }
        s = wave_sum(s);
        if (lane == 0) P.ctl[C_SSX + row] = s;
    }
    for (int idx = blockIdx.x * 512 + tid; idx < M_TOK * 32; idx += G * 512) {
        const int row = idx >> 5, i = idx & 31;
        const float inv = ex2(-(float)i * 0.41524101186092029f);
        const float ang = (float)P.pos[row] * inv;
        const float nrev = rintf(ang * 0.15915494309189535f);
        float rr = fmaf(-nrev, 6.2831854820251465f, ang); rr = fmaf(-nrev, -1.7484555e-7f, rr);
        const float xf = rr * 0.15915494309189535f;
        P.cosT[idx] = __builtin_amdgcn_cosf(xf); P.sinT[idx] = __builtin_amdgcn_sinf(xf);
    }
}

DI void rope_kr(const int tid, const Ptrs& P) {
    for (int idx = blockIdx.x * 512 + tid; idx < M_TOK * 32; idx += gridDim.x * 512) {
        const int row = idx >> 5, i = idx & 31;
        const float x1 = bf2f(P.proj[(size_t)row * DINP + OFF_KR + i]), x2 = bf2f(P.proj[(size_t)row * DINP + OFF_KR + 32 + i]);
        const float c = P.cosT[idx], s = P.sinT[idx];
        const bf16_t o1 = f2bf(x1 * c - x2 * s), o2 = f2bf(x2 * c + x1 * s);
        bf16_t* dst = P.kc + (size_t)row * NUQ + 128 + i;
#pragma unroll
        for (int hd = 0; hd < NHEAD; ++hd) { dst[hd * 192] = o1; dst[hd * 192 + 32] = o2; }
    }
}

DI int crow(int i, int h) { return (i & 3) + 8 * (i >> 2) + 4 * h; }

DI void gmlp_item(const int tid, LAS unsigned char* lds, int item, const Ptrs& P, int l, bool accum = true) {
    const int wid = tid >> 6, lane = tid & 63;
    const int bc = item >> 3, g = item & 7, row0 = bc * 128;
    LAS unsigned char* Wl = lds; LAS unsigned char* Vt = lds + 128 * 272;
    const int ti = wid >> 1, djb = (wid & 1) * 2, r = lane & 31, h = lane >> 5;
    const int s = tid >> 2, d0 = (tid & 3) * 32;
    const bf16_t* vsrc = P.proj + (size_t)(row0 + s) * DINP + OFF_VA + g * 128 + d0;
    const float* wsrc = P.a_w_s + ((size_t)(l * 8 + g) * 128 + s) * 128 + d0;
    const float* gsrc = P.a_g_v + (l * 8 + g) * 128 + d0;
    u32x4 vw[4]; f32x4 ww[8], gw[8];
#pragma unroll
    for (int c = 0; c < 4; ++c) vw[c] = *(const u32x4*)(vsrc + 8 * c);
#pragma unroll
    for (int c = 0; c < 8; ++c) { ww[c] = *(const f32x4*)(wsrc + 4 * c); gw[c] = *(const f32x4*)(gsrc + 4 * c); }
    const int t = 32 * ti + r, row = row0 + t;
    const float bias = P.a_b_s[(l * 8 + g) * 128 + t];
    const bf16_t* up = P.proj + (size_t)row * DINP + OFF_UA + g * 128 + 32 * djb + 4 * h;
    const bf16_t* zp = P.proj + (size_t)row * DINP + OFF_ZA + g * 128 + 32 * djb + 4 * h;
    bf16_t* yp = P.yg + (size_t)row * DM + g * 128 + 32 * djb + 4 * h;
    u32x2 uv[2][4], zv[2][4];
#pragma unroll
    for (int jj = 0; jj < 2; ++jj)
#pragma unroll
        for (int g4 = 0; g4 < 4; ++g4) { uv[jj][g4] = *(const u32x2*)(up + 32 * jj + 8 * g4); zv[jj][g4] = *(const u32x2*)(zp + 32 * jj + 8 * g4); }
    {
        float v[32]; float ss = 0.f;
#pragma unroll
        for (int c = 0; c < 4; ++c)
#pragma unroll
            for (int k = 0; k < 4; ++k) { const float a = gelu_tanh(bflo(vw[c][k])), b = gelu_tanh(bfhi(vw[c][k])); v[8 * c + 2 * k] = a; v[8 * c + 2 * k + 1] = b; ss += a * a + b * b; }
        ss += __shfl_xor(ss, 1); ss += __shfl_xor(ss, 2);
        const float rs = rsqrtf(ss * (1.f / 128.f) + EPS);
#pragma unroll
        for (int j = 0; j < 32; ++j) *(LAS bf16_t*)(Vt + (d0 + j) * 272 + s * 2) = f2bf(v[j] * rs * gw[j >> 2][j & 3]);
    }
    {
#pragma unroll
        for (int c = 0; c < 4; ++c) { f32x4 a = ww[2 * c], b = ww[2 * c + 1];
#pragma unroll
            for (int k = 0; k < 4; ++k) { if (d0 + 8 * c + k > s) a[k] = 0.f; if (d0 + 8 * c + 4 + k > s) b[k] = 0.f; }
            u32x4 w; w.x = pk2(a[0], a[1]); w.y = pk2(a[2], a[3]); w.z = pk2(b[0], b[1]); w.w = pk2(b[2], b[3]);
            *(LAS u32x4*)(Wl + s * 272 + (d0 + 8 * c) * 2) = w; }
    }
    __syncthreads();
    f32x16 D[2];
#pragma unroll
    for (int i = 0; i < 16; ++i) { D[0][i] = 0.f; D[1][i] = 0.f; }
#pragma unroll
    for (int st = 0; st < 8; ++st) {
        const bf16x8 af = *(const LAS bf16x8*)(Wl + (32 * ti + r) * 272 + (16 * st + 8 * h) * 2);
#pragma unroll
        for (int jj = 0; jj < 2; ++jj) { const bf16x8 bfr = *(const LAS bf16x8*)(Vt + (32 * (djb + jj) + r) * 272 + (16 * st + 8 * h) * 2);
            D[jj] = __builtin_amdgcn_mfma_f32_32x32x16_bf16(bfr, af, D[jj], 0, 0, 0); }
    }
    float sq = 0.f;
#pragma unroll
    for (int jj = 0; jj < 2; ++jj)
#pragma unroll
        for (int g4 = 0; g4 < 4; ++g4) {
            const u32x2 uu = uv[jj][g4], zz = zv[jj][g4];
            const float y0 = gelu_tanh(bflo(uu.x)) * (D[jj][4 * g4 + 0] + bias), y1 = gelu_tanh(bfhi(uu.x)) * (D[jj][4 * g4 + 1] + bias);
            const float y2 = gelu_tanh(bflo(uu.y)) * (D[jj][4 * g4 + 2] + bias), y3 = gelu_tanh(bfhi(uu.y)) * (D[jj][4 * g4 + 3] + bias);
            sq += (y0 * y0 + y1 * y1) + (y2 * y2 + y3 * y3);
            u32x2 o; o.x = pk2(y0 * silu(bflo(zz.x)), y1 * silu(bfhi(zz.x))); o.y = pk2(y2 * silu(bflo(zz.y)), y3 * silu(bfhi(zz.y)));
            *(u32x2*)(yp + 32 * jj + 8 * g4) = o;
        }
    sq += __shfl_xor(sq, 32);
    if (h == 0 && accum) atomic_addf(P.ctl + C_SSA + l * M_TOK + row, sq);
    __syncthreads();
}

template <int TYPE>
DI void attn_item(const int tid, LAS unsigned char* lds, int bh, int qb, const Ptrs& P, int l, bool accum = true) {
    constexpr int DQK = TYPE == 0 ? 192 : 128, NT = DQK / 16, KSTR = DQK * 2 + 16, VSTR = 144, KBUF = 64 * KSTR, VBUF = 128 * VSTR, BUFB = KBUF + VBUF;
    const int wid = __builtin_amdgcn_readfirstlane(tid >> 6), lane = tid & 63, r = lane & 31, h = lane >> 5;
    const int b = bh / NHEAD, head = bh % NHEAD;
    const int qrow = qb * 256 + 32 * wid + r, grow = b * SEQ + qrow;
    const int pr = (r & ~12) | ((r & 4) << 1) | ((r & 8) >> 1);

    constexpr int CPR_K = DQK / 8 + 1, NKP = CPR_K, NKI = (NKP + 7) / 8, NVP = 18, NVI = 3;
    constexpr int KLD = TYPE == 1 ? DINP : NUQ;
    const char* kbase = TYPE == 1 ? (const char*)(P.proj + (size_t)(b * SEQ) * DINP + OFF_KB + head * 128) : (const char*)(P.kc + (size_t)(b * SEQ) * NUQ + head * 192);
    const char* vbase = (const char*)((TYPE == 1 ? P.vbt : P.vct) + (size_t)bh * 128 * SEQ);
    unsigned koff[NKI], voff[NVI];
#pragma unroll
    for (int i = 0; i < NKI; ++i) { const int c = tid + 512 * i, row = c / CPR_K; int part = c - row * CPR_K; part = part > CPR_K - 2 ? CPR_K - 2 : part; koff[i] = (unsigned)(row * (KLD * 2) + part * 16); }
#pragma unroll
    for (int i = 0; i < NVI; ++i) { const int c = tid + 512 * i, d = c / 9; int part = c - d * 9; part = part > 7 ? 7 : part; voff[i] = (unsigned)((((part >> 1) * 128 + d) * 16 + (part & 1) * 8) * 2); }

    const int ntiles = 4 * (qb + 1), jd = 4 * qb + (wid >> 1);
#define ATT_DMA(jt, buf) do { const char* _kb = kbase + (size_t)(jt) * (64 * KLD * 2); const char* _vb = vbase + (size_t)(jt) * 16384; \
        _Pragma("unroll") for (int _i = 0; _i < NKI; ++_i) if (wid + 8 * _i < NKP) \
            __builtin_amdgcn_global_load_lds((const unsigned*)(_kb + koff[_i]), (LAS unsigned*)((buf) + (wid + 8 * _i) * 1024), 16, 0, 0); \
        _Pragma("unroll") for (int _i = 0; _i < NVI; ++_i) if (wid + 8 * _i < NVP) \
            __builtin_amdgcn_global_load_lds((const unsigned*)(_vb + voff[_i]), (LAS unsigned*)((buf) + KBUF + (wid + 8 * _i) * 1024), 16, 0, 0); } while (0)
#define ATT_WAIT() asm volatile("s_waitcnt vmcnt(0)" ::: "memory")
    ATT_DMA(ntiles - 1, lds);
    bf16x8 qf[NT];
    if constexpr (TYPE == 1) {
        const bf16_t* qp = P.proj + (size_t)grow * DINP + OFF_QB + head * 128 + 8 * h;
#pragma unroll
        for (int t = 0; t < NT; ++t) qf[t] = *(const bf16x8*)(qp + 16 * t);
    } else {
        const bf16_t* qp = P.qc + (size_t)grow * NUQ + head * 192 + 8 * h;
#pragma unroll
        for (int t = 0; t < NT; ++t) qf[t] = *(const bf16x8*)(qp + 16 * t);
#pragma unroll
        for (int tt = 0; tt < 2; ++tt) {
            const float* cp = P.cosT + grow * 32 + 16 * tt + 8 * h; const float* sp = P.sinT + grow * 32 + 16 * tt + 8 * h;
            const f32x4 c0 = *(const f32x4*)cp, c1 = *(const f32x4*)(cp + 4), s0 = *(const f32x4*)sp, s1 = *(const f32x4*)(sp + 4);
            const u32x4 a = __builtin_bit_cast(u32x4, qf[8 + tt]), bb = __builtin_bit_cast(u32x4, qf[10 + tt]);
            u32x4 o1, o2;
#pragma unroll
            for (int k = 0; k < 4; ++k) {
                const float cl = k < 2 ? c0[2 * k] : c1[2 * k - 4], ch = k < 2 ? c0[2 * k + 1] : c1[2 * k - 3];
                const float sl = k < 2 ? s0[2 * k] : s1[2 * k - 4], sh = k < 2 ? s0[2 * k + 1] : s1[2 * k - 3];
                const float x1l = bflo(a[k]), x1h = bfhi(a[k]), x2l = bflo(bb[k]), x2h = bfhi(bb[k]);
                o1[k] = pk2(x1l * cl - x2l * sl, x1h * ch - x2h * sh);
                o2[k] = pk2(x2l * cl + x1l * sl, x2h * ch + x1h * sh);
            }
            qf[8 + tt] = __builtin_bit_cast(bf16x8, o1); qf[10 + tt] = __builtin_bit_cast(bf16x8, o2);
        }
    }

    f32x16 O[4];
#pragma unroll
    for (int d = 0; d < 4; ++d)
#pragma unroll
        for (int i = 0; i < 16; ++i) O[d][i] = 0.f;
    float m_run = -INFINITY, l_run = 0.f, carry = (TYPE == 1) ? 1.f : 0.f;

    ATT_WAIT(); __syncthreads();
    for (int it = 0; it < ntiles; ++it) {
        const int jt = ntiles - 1 - it;
        LAS unsigned char* cur = lds + (it & 1) * BUFB; LAS unsigned char* nxt = lds + ((it + 1) & 1) * BUFB;
        if (it + 1 < ntiles) ATT_DMA(jt - 1, nxt);
        bool wdone = false;
        if constexpr (TYPE == 1) wdone = __all(carry < 3.5527137e-15f);
        if (jt <= jd && !wdone) {
            const bool diag = (jt == jd);
            f32x16 S[2];
            const float negm = (TYPE == 0 && !diag) ? -m_run : 0.f;
#pragma unroll
            for (int kb = 0; kb < 2; ++kb) {
#pragma unroll
                for (int i = 0; i < 16; ++i) S[kb][i] = negm;
#pragma unroll
                for (int t = 0; t < NT; ++t) { const bf16x8 kf = *(const LAS bf16x8*)(cur + (32 * kb + pr) * KSTR + (16 * t + 8 * h) * 2);
                    S[kb] = __builtin_amdgcn_mfma_f32_32x32x16_bf16(kf, qf[t], S[kb], 0, 0, 0); }
            }
            if constexpr (TYPE == 0) {
                if (diag) {
#pragma unroll
                    for (int kb = 0; kb < 2; ++kb)
#pragma unroll
                        for (int i = 0; i < 16; ++i) { const int key = jt * 64 + 32 * kb + 16 * (i >> 3) + 8 * h + (i & 7); if (key > qrow) S[kb][i] = -INFINITY; }
                }
                float mx = S[0][0];
#pragma unroll
                for (int i = 1; i < 16; ++i) mx = fmaxf(mx, S[0][i]);
#pragma unroll
                for (int i = 0; i < 16; ++i) mx = fmaxf(mx, S[1][i]);
                mx = fmaxf(mx, __shfl_xor(mx, 32));
                const bool need = !diag && __any(mx > 8.f);
                const float dlt = diag ? mx : (mx > 8.f ? mx : 0.f);
                m_run = diag ? mx : m_run + dlt;
#pragma unroll
                for (int kb = 0; kb < 2; ++kb)
#pragma unroll
                    for (int i = 0; i < 16; ++i) S[kb][i] -= dlt;
                if (need) {
                    const float alpha = ex2(-dlt);
                    l_run *= alpha;
#pragma unroll
                    for (int d = 0; d < 4; ++d) O[d] = O[d] * alpha;
                }
#pragma unroll
                for (int kb = 0; kb < 2; ++kb)
#pragma unroll
                    for (int i = 0; i < 16; ++i) { const float p = ex2(S[kb][i]); l_run += p; S[kb][i] = p; }
            } else {
#pragma unroll
                for (int kb = 1; kb >= 0; --kb) {
                    float om[16]; float PA = 1.f, PB = 1.f;
#pragma unroll
                    for (int i = 0; i < 16; ++i) {
                        const float z = __builtin_amdgcn_fmed3f(S[kb][i], -60.f, 60.f);
                        const float ez = ex2(-z), bt = rcpf(1.f + ez);
                        const int key = jt * 64 + 32 * kb + 16 * (i >> 3) + 8 * h + (i & 7);
                        const bool valid = !diag || (key < qrow);
                        om[i] = valid ? ez * bt : 1.f;
                        S[kb][i] = valid ? bt : 0.f;
                        if (i < 8) PA *= om[i]; else PB *= om[i];
                    }
                    const float PAp = __shfl_xor(PA, 32), PBp = __shfl_xor(PB, 32);
                    float run = carry * (h == 0 ? PBp : 1.f);
#pragma unroll
                    for (int i = 15; i >= 8; --i) { const float a = S[kb][i] * run; run *= om[i]; S[kb][i] = a; }
                    run = carry * PB * PBp * (h == 0 ? PAp : 1.f);
#pragma unroll
                    for (int i = 7; i >= 0; --i) { const float a = S[kb][i] * run; run *= om[i]; S[kb][i] = a; }
                    carry *= (PA * PAp) * (PB * PBp);
                }
            }
            const LAS unsigned char* Vb = cur + KBUF;
#pragma unroll
            for (int kb = 0; kb < 2; ++kb)
#pragma unroll
                for (int s = 0; s < 2; ++s) {
                    u32x4 pw;
#pragma unroll
                    for (int k = 0; k < 4; ++k) pw[k] = pk2(S[kb][8 * s + 2 * k], S[kb][8 * s + 2 * k + 1]);
                    const bf16x8 pf = __builtin_bit_cast(bf16x8, pw);
#pragma unroll
                    for (int d = 0; d < 4; ++d) { const bf16x8 vf = *(const LAS bf16x8*)(Vb + (32 * d + r) * VSTR + (32 * kb + 16 * s + 8 * h) * 2);
                        O[d] = __builtin_amdgcn_mfma_f32_32x32x16_bf16(vf, pf, O[d], 0, 0, 0); }
                }
        }
        ATT_WAIT();
        if constexpr (TYPE == 1) {
            const int alld = __syncthreads_and((jt <= jd && __all(carry < 3.5527137e-15f)) ? 1 : 0);
            if (alld) break;
        } else __syncthreads();
    }
#undef ATT_DMA
#undef ATT_WAIT
    if constexpr (TYPE == 0) { const float lt = l_run + __shfl_xor(l_run, 32); const float inv = 1.f / lt;
#pragma unroll
        for (int d = 0; d < 4; ++d) O[d] = O[d] * inv; }
    float sq = 0.f;
#pragma unroll
    for (int d = 0; d < 4; ++d)
#pragma unroll
        for (int i = 0; i < 16; ++i) sq += O[d][i] * O[d][i];
    sq += __shfl_xor(sq, 32);
    float* ssp = P.ctl + (TYPE == 0 ? C_SSC : C_SSB) + l * M_TOK;
    if (h == 0 && accum) atomic_addf(ssp + grow, sq);
    const bf16_t* zp = P.proj + (size_t)grow * DINP + (TYPE == 0 ? OFF_ZC : OFF_ZB) + head * 128 + 4 * h;
    bf16_t* yp = P.yg + (size_t)grow * DM + (TYPE == 0 ? 2560 : 1024) + head * 128 + 4 * h;
    u32x2 zv[4][4];
#pragma unroll
    for (int d = 0; d < 4; ++d)
#pragma unroll
        for (int g4 = 0; g4 < 4; ++g4) zv[d][g4] = *(const u32x2*)(zp + 32 * d + 8 * g4);
#pragma unroll
    for (int d = 0; d < 4; ++d)
#pragma unroll
        for (int g4 = 0; g4 < 4; ++g4) {
            const u32x2 zz = zv[d][g4];
            u32x2 o; o.x = pk2(O[d][4 * g4] * silu(bflo(zz.x)), O[d][4 * g4 + 1] * silu(bfhi(zz.x)));
            o.y = pk2(O[d][4 * g4 + 2] * silu(bflo(zz.y)), O[d][4 * g4 + 3] * silu(bfhi(zz.y)));
            *(u32x2*)(yp + 32 * d + 8 * g4) = o;
        }
}

__global__ void __launch_bounds__(512, 2) mega(Args a) {
    extern __shared__ __attribute__((aligned(16))) unsigned char lds_raw[];
    LAS unsigned char* lds = (LAS unsigned char*)lds_raw;
    cg::grid_group grid = cg::this_grid();
    Ptrs P;
    P.x = a.in[0]; P.pos = (const int*)a.in[1]; P.g_pre = a.in[2]; P.w_in = a.in[3]; P.a_g_v = a.in[4]; P.a_w_s = a.in[5]; P.a_b_s = a.in[6];
    P.c_g_q = a.in[7]; P.c_g_kv = a.in[8]; P.c_w_uq = a.in[9]; P.c_w_ukv = a.in[10]; P.g_out = a.in[11]; P.w_out = a.in[12]; P.g_final = a.in[13];
    P.out = a.out; unsigned char* ws = a.ws;
    P.ctl = (float*)(ws + WS_CTL); P.cnt = (unsigned*)(ws + WS_CTL) + C_CNT;
    P.win = (bf16_t*)(ws + WS_WIN); P.wout = (bf16_t*)(ws + WS_WOUT); P.wuq = (bf16_t*)(ws + WS_WUQ); P.wukv = (bf16_t*)(ws + WS_WUKV);
    P.xb = (bf16_t*)(ws + WS_XB); P.proj = (bf16_t*)(ws + WS_PROJ); P.vbt = (bf16_t*)(ws + WS_VBT); P.qc = (bf16_t*)(ws + WS_QC);
    P.kc = (bf16_t*)(ws + WS_KC); P.vct = (bf16_t*)(ws + WS_VCT); P.yg = (bf16_t*)(ws + WS_YG);
    P.cosT = (float*)(ws + WS_COS); P.sinT = (float*)(ws + WS_SIN);
    const int G = gridDim.x, bid = blockIdx.x;
    const int wave_id = __builtin_amdgcn_readfirstlane((int)threadIdx.x >> 6);

    for (int ph = a.ph_lo; ph < a.ph_hi; ++ph) {
        int tid; asm volatile("v_mbcnt_lo_u32_b32 %0, -1, 0\n\tv_mbcnt_hi_u32_b32 %0, -1, %0" : "=v"(tid)); tid += wave_id * 64;
        if (ph == 0) {
            phase0(tid, lds, P);
            __syncthreads();
        } else if (ph == 9) {
            const int lane = tid & 63, gw = bid * 8 + (tid >> 6), NGW = G * 8;
            const float* ss = P.ctl + C_SSX + 2 * M_TOK;
            for (int row = gw; row < M_TOK; row += NGW) {
                const float rs = rsqrtf(ss[row] * (1.f / 4096.f) + EPS);
                f32x4* o = (f32x4*)(P.out + (size_t)row * DM) + lane; const f32x4* gf = (const f32x4*)P.g_final + lane;
                const u32x2* xi = (const u32x2*)(P.xb + (size_t)row * DM) + lane;
                u32x2 xv[16]; f32x4 gv[16];
#pragma unroll
                for (int j = 0; j < 16; ++j) { xv[j] = xi[64 * j]; gv[j] = gf[64 * j]; }
#pragma unroll
                for (int j = 0; j < 16; ++j) { const u32x2 w = xv[j]; const f32x4 v = {bflo(w.x), bfhi(w.x), bflo(w.y), bfhi(w.y)}; o[64 * j] = v * rs * gv[j]; }
            }
        } else {
            const int l = (ph - 1) >> 2, k = (ph - 1) & 3;
            if (k == 0) {
                pg8::Gemm g{P.xb, P.win + (size_t)l * DINP * DM, DM, DM, DM, M_TOK, DINP};
                pg8::StaticOrder S; S.init(M_TOK, DINP, G, bid);
                EpiInProj E{P.proj, P.vbt, P.ctl + C_SSX + l * M_TOK, P.ctl + C_SSQ + l * M_TOK, P.ctl + C_SSKV + l * M_TOK, true, lds + XPOSE_OFF + (tid >> 6) * 1024};
                pg8::gemm_phase<EpiInProj>(tid, lds, g, S, E);
            } else if (k == 1) {
                {
                rope_kr(tid, P);
                for (int it = bid; it < 512; it += G) { gmlp_item(tid, lds, it, P, l, true);
                }
                {
                    pg8::Gemm g{P.proj + OFF_CQ, P.wuq + (size_t)l * NUQ * QL, DINP, QL, QL, M_TOK, NUQ};
                    pg8::StaticOrder S; S.init(M_TOK, NUQ, G, bid);
                    EpiUQ E{P.qc, P.ctl + C_SSQ + l * M_TOK};
                    pg8::gemm_phase<EpiUQ>(tid, lds, g, S, E);
                }
                {
                    pg8::Gemm g{P.proj + OFF_CKV, P.wukv + (size_t)l * NUKV * KVL, DINP, KVL, KVL, M_TOK, NUKV};
                    pg8::StaticOrder S; S.init(M_TOK, NUKV, G, (bid + G / 2) % G);
                    EpiUKV E{P.kc, P.vct, P.ctl + C_SSKV + l * M_TOK, lds + XPOSE_OFF + (tid >> 6) * 1024};
                    pg8::gemm_phase<EpiUKV>(tid, lds, g, S, E);
                }
                }
            } else if (k == 2) {
                volatile LAS unsigned* qw = (volatile LAS unsigned*)(lds + RING_BYTES);
                { const int rep = 0;
                for (;;) {
                    if (tid == 0) *qw = atomicAdd(P.cnt + l + 2 * rep, 1u);
                    __syncthreads();
                    const unsigned idx = *qw;
                    __syncthreads();
                    if (idx >= 768u) break;
                    const int qb = 15 - (int)(idx / 48u), rem = (int)(idx % 48u), type = rem / 24, bh = rem % 24;
                    int t2 = tid; asm volatile("" : "+v"(t2));
                    if (type == 0) attn_item<0>(t2, lds, bh, qb, P, l, rep == 0); else attn_item<1>(t2, lds, bh, qb, P, l, rep == 0);
                }
                }
            } else {
                pg8::Gemm g{P.yg, P.wout + (size_t)l * DM * DM, DM, DM, DM, M_TOK, DM};
                pg8::StaticOrder S; S.init(M_TOK, DM, G, bid);
                EpiOut E{P.xb, (float*)nullptr, P.xb, P.ctl + C_SSX + (l + 1) * M_TOK,
                         P.ctl + C_SSA + l * M_TOK, P.ctl + C_SSB + l * M_TOK, P.ctl + C_SSC + l * M_TOK, true, (LAS float*)(lds + XPOSE_OFF)};
                pg8::gemm_phase<EpiOut>(tid, lds, g, S, E);
            }
        }
        if (ph + 1 < a.ph_hi) grid.sync();
    }
}

extern "C" void kernel_launch(void* const* d_in, const int* in_sizes, int n_in, void* d_out, int out_size, void* d_ws, size_t ws_size, hipStream_t stream) {
    static int grid = 0;
    if (grid == 0) {
        if (n_in != 14 || ws_size < WS_END || out_size != M_TOK * DM) { fprintf(stderr, "kernel_launch: unexpected shapes (n_in %d, ws %zu, out %d)\n", n_in, ws_size, out_size); grid = -1; return; }
        int dev = 0, cus = 0, per_cu = 0;
        hipGetDevice(&dev);
        hipDeviceGetAttribute(&cus, hipDeviceAttributeMultiprocessorCount, dev);
        if (hipFuncSetAttribute((const void*)mega, hipFuncAttributeMaxDynamicSharedMemorySize, LDS_BYTES) != hipSuccess) { fprintf(stderr, "kernel_launch: hipFuncSetAttribute failed\n"); grid = -1; return; }
        if (hipOccupancyMaxActiveBlocksPerMultiprocessor(&per_cu, (const void*)mega, 512, LDS_BYTES) != hipSuccess || per_cu < 1) { fprintf(stderr, "kernel_launch: occupancy query gives %d\n", per_cu); per_cu = 1; }
        (void)hipGetLastError();
        grid = cus * 1;
    }
    if (grid < 0) return;
    hipMemsetAsync((char*)d_ws + WS_CTL, 0, CTL_BYTES, stream);
    Args a{};
    for (int i = 0; i < 14; ++i) a.in[i] = (const float*)d_in[i];
    a.out = (float*)d_out; a.ws = (unsigned char*)d_ws;
#if N_LAUNCH == 1
    a.ph_lo = 0; a.ph_hi = 10;
    void* args[] = {&a};
    hipError_t e = hipLaunchCooperativeKernel((const void*)mega, dim3(grid), dim3(512), args, LDS_BYTES, stream);
    if (e != hipSuccess) fprintf(stderr, "cooperative launch failed: %s (grid %d)\n", hipGetErrorString(e), grid);
#else
    for (int ph = 0; ph < 10; ++ph) {
        a.ph_lo = ph; a.ph_hi = ph + 1;
        hipLaunchKernelGGL(mega, dim3(grid), dim3(512), LDS_BYTES, stream, a);
    }
#endif
}
```
